# Optimizing an MI355X kernel written in HIP

```python
import jax
import jax.numpy as jnp
from jax import lax
import numpy as np

D_MODEL = 1024
BATCH = 4
SEQ = 4096
DEPTH = 2

HGRN_WIDTH = D_MODEL // 2
HGRN_HEAD_DIM = 128
HGRN_HEADS = HGRN_WIDTH // HGRN_HEAD_DIM
HGRN_CHUNK = 64
HGRN_PROJ = 4 * HGRN_WIDTH
RWKV_WIDTH = D_MODEL // 2
RWKV_HEAD_DIM = 64
RWKV_HEADS = RWKV_WIDTH // RWKV_HEAD_DIM
RWKV_DECAY_LORA = 64
RWKV_AAA_LORA = 64
RWKV_GATE_LORA = 128
RWKV_LN_EPS = 64e-5
RWKV_PROJ = 3 * RWKV_WIDTH + RWKV_DECAY_LORA + RWKV_AAA_LORA + RWKV_GATE_LORA
AR_PROJ = HGRN_PROJ + RWKV_PROJ
ATTN_HEADS = 8
ATTN_HEAD_DIM = D_MODEL // ATTN_HEADS
MOBA_BLOCK = 256
MOBA_TOPK = 3
MOBA_QCHUNK = 64
ROPE_THETA = 10000.0
D_FF = 4 * D_MODEL
PLE_DIM = 256
N_EVEN = (DEPTH + 1) // 2
N_ODD = DEPTH // 2
NORM_EPS = 1e-6

kernel_name = 'hybrid_hgrn2_rwkv7_moba_trunk'


def rms_norm(x, g, eps=NORM_EPS):
    xf = x.astype(jnp.float32)
    y = xf * lax.rsqrt(jnp.mean(xf * xf, axis=-1, keepdims=True) + eps)
    return (y * g.astype(jnp.float32)).astype(x.dtype)


def head_layer_norm(y, w, b, eps=RWKV_LN_EPS):
    yf = y.astype(jnp.float32)
    mu = jnp.mean(yf, axis=-1, keepdims=True)
    var = jnp.mean(jnp.square(yf - mu), axis=-1, keepdims=True)
    return (yf - mu) * lax.rsqrt(var + eps) * w + b


def rotary(x, pos):
    half = x.shape[-1] // 2
    inv_freq = jnp.power(ROPE_THETA, -jnp.arange(half, dtype=jnp.float32) / half)
    ang = pos.astype(jnp.float32)[:, None] * inv_freq[None, :]
    cos = jnp.cos(ang)[None, :, None, :]
    sin = jnp.sin(ang)[None, :, None, :]
    xf = x.astype(jnp.float32)
    x1, x2 = xf[..., :half], xf[..., half:]
    return jnp.concatenate([x1 * cos - x2 * sin, x2 * cos + x1 * sin], axis=-1).astype(x.dtype)


def token_shift(u):
    return jnp.pad(u[:, :-1], ((0, 0), (1, 0), (0, 0)))


def hgrn2_chunked(q, k, v, log_f):
    B, H, S, dk = q.shape
    dv = v.shape[-1]
    C = HGRN_CHUNK
    n = S // C

    def to_chunks(t):
        return t.reshape(B, H, n, C, t.shape[-1]).transpose(2, 0, 1, 3, 4)

    causal = jnp.tril(jnp.ones((C, C), dtype=bool))

    def step(state, inp):
        qc, kc, vc, gc = inp
        b = jnp.cumsum(gc, axis=2)
        o_inter = jnp.einsum('bhtk,bhkv->bhtv', qc * jnp.exp(b), state)
        diff = jnp.where(causal[None, None, :, :, None],
                         b[:, :, :, None, :] - b[:, :, None, :, :], -jnp.inf)
        scores = jnp.einsum('bhtk,bhsk,bhtsk->bhts', qc, kc, jnp.exp(diff))
        o_intra = jnp.einsum('bhts,bhsv->bhtv', scores, vc)
        b_last = b[:, :, -1:, :]
        state = (state * jnp.exp(b_last)[:, :, 0, :, None]
                 + jnp.einsum('bhsk,bhsv->bhkv', kc * jnp.exp(b_last - b), vc))
        return state, o_inter + o_intra

    state0 = jnp.zeros((B, H, dk, dv), jnp.float32)
    _, o = lax.scan(step, state0, (to_chunks(q), to_chunks(k), to_chunks(v), to_chunks(log_f)))
    return o.transpose(1, 2, 0, 3, 4).reshape(B, H, S, dv)


def rwkv7_scan(r, decay, k, v, kk, a):
    B, S, H, N = r.shape

    def step(state, inp):
        r_t, w_t, k_t, v_t, kk_t, a_t = inp
        sa = jnp.einsum('bhvk,bhk->bhv', state, -kk_t)
        state = (state * w_t[:, :, None, :]
                 + sa[..., None] * (kk_t * a_t)[:, :, None, :]
                 + v_t[..., None] * k_t[:, :, None, :])
        return state, jnp.einsum('bhvk,bhk->bhv', state, r_t)

    xs = (r.transpose(1, 0, 2, 3), decay.transpose(1, 0, 2, 3), k.transpose(1, 0, 2, 3),
          v.transpose(1, 0, 2, 3), kk.transpose(1, 0, 2, 3), a.transpose(1, 0, 2, 3))
    state0 = jnp.zeros((B, H, N, N), jnp.float32)
    _, y = lax.scan(step, state0, xs)
    return y.transpose(1, 0, 2, 3)


def hgrn_rwkv_mixer(h, w_in, w_out, lb, onorm, mu, w0, w2, a0, a2, g2, k_k, k_a, r_k, ln_w, ln_b):
    B, S, _ = h.shape
    u = (h @ w_in).astype(jnp.float32)
    hq, hf, hi, hg, ur = jnp.split(u, [HGRN_WIDTH, 2 * HGRN_WIDTH, 3 * HGRN_WIDTH, HGRN_PROJ], axis=-1)

    def heads(t, n_heads):
        return t.reshape(B, S, n_heads, -1).transpose(0, 2, 1, 3)

    f = lb + (1.0 - lb) * jax.nn.sigmoid(hf)
    o_a = hgrn2_chunked(heads(jax.nn.silu(hq), HGRN_HEADS), heads(1.0 - f, HGRN_HEADS),
                        heads(hi, HGRN_HEADS), heads(jnp.log(f), HGRN_HEADS))
    o_a = rms_norm(o_a.transpose(0, 2, 1, 3), onorm.reshape(HGRN_HEADS, HGRN_HEAD_DIM))
    o_a = o_a.reshape(B, S, HGRN_WIDTH) * jax.nn.silu(hg)

    ur = ur + (token_shift(ur) - ur) * mu
    r, k, v, wd, ad, gd = jnp.split(
        ur, [RWKV_WIDTH, 2 * RWKV_WIDTH, 3 * RWKV_WIDTH, 3 * RWKV_WIDTH + RWKV_DECAY_LORA,
             3 * RWKV_WIDTH + RWKV_DECAY_LORA + RWKV_AAA_LORA], axis=-1)
    w = -jax.nn.softplus(-(w0 + jnp.tanh(wd) @ w2)) - 0.5
    decay = jnp.exp(-jnp.exp(w))
    a = jax.nn.sigmoid(a0 + ad @ a2)
    g = jax.nn.sigmoid(gd) @ g2
    kk = (k * k_k).reshape(B, S, RWKV_HEADS, RWKV_HEAD_DIM)
    kk = kk / jnp.maximum(jnp.sqrt(jnp.sum(kk * kk, axis=-1, keepdims=True)), 1e-12)
    k = k * (1.0 + (a - 1.0) * k_a)

    def rh(t):
        return t.reshape(B, S, RWKV_HEADS, RWKV_HEAD_DIM)

    r4, k4, v4 = rh(r), rh(k), rh(v)
    y = rwkv7_scan(r4, rh(decay), k4, v4, kk, rh(a))
    y = head_layer_norm(y, ln_w.reshape(RWKV_HEADS, RWKV_HEAD_DIM),
                        ln_b.reshape(RWKV_HEADS, RWKV_HEAD_DIM))
    bonus = jnp.sum(r4 * k4 * r_k.reshape(RWKV_HEADS, RWKV_HEAD_DIM), axis=-1, keepdims=True) * v4
    o_b = (y + bonus).reshape(B, S, RWKV_WIDTH) * g

    o = jnp.concatenate([o_a, o_b], axis=-1).astype(h.dtype)
    return o @ w_out


def moba_attention(q, k, v):
    B, H, S, Dh = q.shape
    nb = -(-S // MOBA_BLOCK)
    pad = nb * MOBA_BLOCK - S
    kb = jnp.pad(k, ((0, 0), (0, 0), (0, pad), (0, 0))).reshape(B, H, nb, MOBA_BLOCK, Dh)
    vb = jnp.pad(v, ((0, 0), (0, 0), (0, pad), (0, 0))).reshape(B, H, nb, MOBA_BLOCK, Dh)
    scale = Dh ** -0.5
    q_blk = jnp.arange(S) // MOBA_BLOCK
    n_sel = min(MOBA_TOPK, nb - 1)
    if n_sel > 0:
        k_mean = jnp.mean(kb.astype(jnp.float32), axis=3)
        gate = jnp.einsum('bhsd,bhnd->bhsn', q.astype(jnp.float32), k_mean)
        past = jnp.arange(nb)[None, :] < q_blk[:, None]
        gate = jnp.where(past, gate, -jnp.inf)
        _, sel = lax.top_k(gate, n_sel)
    else:
        sel = jnp.zeros((B, H, S, 0), jnp.int32)
    valid = jnp.arange(n_sel)[None, :] < q_blk[:, None]

    qc_size = MOBA_QCHUNK
    nc = S // qc_size
    q_chunks = q.reshape(B, H, nc, qc_size, Dh).transpose(2, 0, 1, 3, 4)
    sel_chunks = sel.reshape(B, H, nc, qc_size, n_sel).transpose(2, 0, 1, 3, 4)
    valid_chunks = valid.reshape(nc, qc_size, n_sel)
    bi = jnp.arange(B)[:, None, None]
    hi = jnp.arange(H)[None, :, None]

    def attend_chunk(inp):
        c, qc, sel_c, valid_c = inp
        q_pos = c * qc_size + jnp.arange(qc_size)
        own = (c * qc_size) // MOBA_BLOCK
        k_own = lax.dynamic_index_in_dim(kb, own, axis=2, keepdims=False)
        v_own = lax.dynamic_index_in_dim(vb, own, axis=2, keepdims=False)
        k_pos = own * MOBA_BLOCK + jnp.arange(MOBA_BLOCK)
        s_own = jnp.einsum('bhqd,bhkd->bhqk', qc, k_own).astype(jnp.float32) * scale
        scores = [jnp.where(k_pos[None, :] <= q_pos[:, None], s_own, -jnp.inf)]
        for j in range(n_sel):
            k_sel = kb[bi, hi, sel_c[..., j]]
            s = jnp.einsum('bhqd,bhqkd->bhqk', qc, k_sel).astype(jnp.float32) * scale
            scores.append(jnp.where(valid_c[:, j][:, None], s, -jnp.inf))
        probs = jax.nn.softmax(jnp.concatenate(scores, axis=-1), axis=-1).astype(vb.dtype)
        out = jnp.einsum('bhqk,bhkd->bhqd', probs[..., :MOBA_BLOCK], v_own)
        for j in range(n_sel):
            v_sel = vb[bi, hi, sel_c[..., j]]
            p_j = probs[..., (j + 1) * MOBA_BLOCK:(j + 2) * MOBA_BLOCK]
            out = out + jnp.einsum('bhqk,bhqkd->bhqd', p_j, v_sel)
        return out

    o = lax.map(attend_chunk, (jnp.arange(nc), q_chunks, sel_chunks, valid_chunks))
    return o.transpose(1, 2, 0, 3, 4).reshape(B, H, S, Dh)


def moba_mixer(h, w_qkv, w_o, q_gain, k_gain, pos):
    B, S, D = h.shape
    q, k, v = jnp.split(h @ w_qkv, 3, axis=-1)
    q = q.reshape(B, S, ATTN_HEADS, ATTN_HEAD_DIM)
    k = k.reshape(B, S, ATTN_HEADS, ATTN_HEAD_DIM)
    v = v.reshape(B, S, ATTN_HEADS, ATTN_HEAD_DIM)
    q = rotary(rms_norm(q, q_gain), pos)
    k = rotary(rms_norm(k, k_gain), pos)
    o = moba_attention(q.transpose(0, 2, 1, 3), k.transpose(0, 2, 1, 3), v.transpose(0, 2, 1, 3))
    return o.transpose(0, 2, 1, 3).reshape(B, S, D) @ w_o


def setup_inputs(seed: int = 0) -> dict:
    key = jax.random.key(seed)
    ks = iter(jax.random.split(key, 40))

    def normal(shape, scale):
        return jax.random.normal(next(ks), shape, jnp.float32) * scale

    def gain(shape):
        return 1.0 + normal(shape, 0.05)

    D = D_MODEL
    mix_w = HGRN_WIDTH + RWKV_WIDTH
    return {
        'x': normal((BATCH, SEQ, D), 1.0),
        'p': normal((DEPTH, BATCH, SEQ, PLE_DIM), 1.0),
        'attn_norm': gain((DEPTH, D)),
        'mlp_norm': gain((DEPTH, D)),
        'w_in_ar': normal((N_EVEN, D, AR_PROJ), D ** -0.5),
        'w_out_ar': normal((N_EVEN, mix_w, D), mix_w ** -0.5),
        'hgrn_lb': normal((DEPTH + 1, HGRN_WIDTH), 0.5),
        'hgrn_onorm': gain((N_EVEN, HGRN_WIDTH)),
        'rwkv_mu': jax.random.uniform(next(ks), (N_EVEN, RWKV_PROJ), jnp.float32),
        'rwkv_w0': jax.random.uniform(next(ks), (N_EVEN, RWKV_WIDTH), jnp.float32, -3.0, 1.0),
        'rwkv_w2': normal((N_EVEN, RWKV_DECAY_LORA, RWKV_WIDTH), 0.1 * RWKV_DECAY_LORA ** -0.5),
        'rwkv_a0': normal((N_EVEN, RWKV_WIDTH), 0.5),
        'rwkv_a2': normal((N_EVEN, RWKV_AAA_LORA, RWKV_WIDTH), 0.1 * RWKV_AAA_LORA ** -0.5),
        'rwkv_g2': normal((N_EVEN, RWKV_GATE_LORA, RWKV_WIDTH), RWKV_GATE_LORA ** -0.5),
        'rwkv_kk': 0.85 + normal((N_EVEN, RWKV_WIDTH), 0.05),
        'rwkv_ka': 1.0 + normal((N_EVEN, RWKV_WIDTH), 0.05),
        'rwkv_rk': normal((N_EVEN, RWKV_WIDTH), 0.1),
        'rwkv_ln_w': gain((N_EVEN, RWKV_WIDTH)),
        'rwkv_ln_b': normal((N_EVEN, RWKV_WIDTH), 0.02),
        'w_qkv': normal((N_ODD, D, 3 * D), D ** -0.5),
        'w_o_attn': normal((N_ODD, D, D), D ** -0.5),
        'q_norm': gain((N_ODD, ATTN_HEAD_DIM)),
        'k_norm': gain((N_ODD, ATTN_HEAD_DIM)),
        'w_up': normal((DEPTH, D, D_FF), D ** -0.5),
        'w_down': normal((DEPTH, D_FF, D), D_FF ** -0.5),
        'ple_proj': normal((DEPTH, PLE_DIM, D), PLE_DIM ** -0.5),
        'ple_norm': gain((DEPTH, D)),
        'ple_gate': normal((DEPTH, D, D), D ** -0.5),
    }


def reference(x, p, attn_norm, mlp_norm, w_in_ar, w_out_ar, hgrn_lb, hgrn_onorm,
              rwkv_mu, rwkv_w0, rwkv_w2, rwkv_a0, rwkv_a2, rwkv_g2, rwkv_kk, rwkv_ka, rwkv_rk,
              rwkv_ln_w, rwkv_ln_b, w_qkv, w_o_attn, q_norm, k_norm, w_up, w_down,
              ple_proj, ple_norm, ple_gate):
    S = x.shape[1]
    pos = jnp.arange(S)
    lb_all = jnp.cumsum(jax.nn.softmax(hgrn_lb.astype(jnp.float32), axis=0), axis=0)
    for l in range(DEPTH):
        h = rms_norm(x, attn_norm[l])
        if l % 2 == 0:
            e = l // 2
            mix = hgrn_rwkv_mixer(h, w_in_ar[e], w_out_ar[e], lb_all[l], hgrn_onorm[e],
                                  rwkv_mu[e], rwkv_w0[e], rwkv_w2[e], rwkv_a0[e], rwkv_a2[e],
                                  rwkv_g2[e], rwkv_kk[e], rwkv_ka[e], rwkv_rk[e],
                                  rwkv_ln_w[e], rwkv_ln_b[e])
        else:
            o = l // 2
            mix = moba_mixer(h, w_qkv[o], w_o_attn[o], q_norm[o], k_norm[o], pos)
        x = x + mix.astype(x.dtype)
        h = rms_norm(x, mlp_norm[l])
        x = x + jnp.square(jax.nn.relu(h @ w_up[l])) @ w_down[l]
        ple = rms_norm(p[l] @ ple_proj[l], ple_norm[l])
        x = x + ple * jax.nn.sigmoid(x @ ple_gate[l])
    return x
```

```cpp
#include <hip/hip_runtime.h>
#include <hip/hip_cooperative_groups.h>
#include <cstdio>
#include <cstdint>
namespace cg = cooperative_groups;

#ifndef ONE_LAUNCH
#define ONE_LAUNCH 1
#endif

typedef unsigned short bf16_t;
typedef short bf16x8 __attribute__((ext_vector_type(8)));
typedef short bf16x4 __attribute__((ext_vector_type(4)));
typedef float f32x16 __attribute__((ext_vector_type(16)));
typedef float f32x4 __attribute__((ext_vector_type(4)));
typedef unsigned u32x4 __attribute__((ext_vector_type(4)));
typedef unsigned u32x2 __attribute__((ext_vector_type(2)));
#define DI __device__ __forceinline__
#define MFMA32(a, b, c) __builtin_amdgcn_mfma_f32_32x32x16_bf16((a), (b), (c), 0, 0, 0)

constexpr int M = 16384;
constexpr size_t MiB = 1u << 20;
constexpr size_t W_WIN = 0, W_WOUT = 7864320, W_UP0 = 9961472, W_DN0 = 18350080, W_PPJ0 = 26738688, W_PGT0 = 27262976,
                 W_W2 = 29360128, W_A2 = 29425664, W_G2 = 29491200;
constexpr size_t XB_A = 29 * MiB, XB_B = 61 * MiB;
constexpr size_t RSS_A = 93 * MiB, RSS_B = 94 * MiB, RSS_P = 95 * MiB;
constexpr size_t KMEAN = 96 * MiB, BONUS = 96 * MiB + 262144, LBOFF = 96 * MiB + 786432, RSS_X0 = 96 * MiB + 790528;
constexpr size_t R0 = 97 * MiB;
constexpr size_t U_OFF = R0, LOGD = R0 + 120 * MiB, AARR = R0 + 136 * MiB, BND = R0 + 152 * MiB;
constexpr size_t Y_OFF = XB_B, OA_OFF = XB_B + 16 * MiB;
constexpr size_t ACT = R0, PPB = R0 + 64 * MiB;
constexpr size_t W1 = R0 + 128 * MiB;
constexpr size_t W_QKV = W1, W_WO = W1 + 6291456, W_UP1 = W_WO + 2097152, W_DN1 = W_UP1 + 8388608, W_PPJ1 = W_DN1 + 8388608, W_PGT1 = W_PPJ1 + 524288;
constexpr size_t ROPE = R0 + 155 * MiB;
constexpr size_t QKV = R0, VT = R0 + 96 * MiB;
constexpr size_t WS_NEED = 256 * MiB;
constexpr int LDS_BYTES = 65536 + 1024;
constexpr float QSCALE = 0.08838834764831845f * 1.4426950408889634f;

struct Pm { const float* in[28]; float* out; char* ws; };

DI int tidx() { int t = __builtin_amdgcn_workitem_id_x(); asm volatile("" : "+v"(t)); return t; }
DI float bf2f(bf16_t v) { return __uint_as_float(((unsigned)v) << 16); }
DI bf16_t f2bf(float x) { unsigned u = __float_as_uint(x); u += 0x7fffu + ((u >> 16) & 1u); return (bf16_t)(u >> 16); }
DI unsigned pack2(float lo, float hi) { return (unsigned)f2bf(lo) | ((unsigned)f2bf(hi) << 16); }
DI float lo16(unsigned u) { return __uint_as_float(u << 16); }
DI float hi16(unsigned u) { return __uint_as_float(u & 0xffff0000u); }
DI float sigmoidf_(float x) { return 1.f / (1.f + __expf(-x)); }
template <int CTRL> DI float dppf(float x) { return __int_as_float(__builtin_amdgcn_update_dpp(0, __float_as_int(x), CTRL, 0xF, 0xF, true)); }
DI float allreduce16(float x) { x += dppf<0xB1>(x); x += dppf<0x4E>(x); x += dppf<0x141>(x); x += dppf<0x140>(x); return x; }
DI float allreduce32(float x) { x = allreduce16(x); x += __shfl_xor(x, 16); return x; }
DI float allreduce64(float x) { x = allreduce32(x); x += __shfl_xor(x, 32); return x; }

enum { EPI_WIN = 0, EPI_LW, EPI_LA, EPI_POSTB, EPI_RES, EPI_UP, EPI_PP, EPI_GATE, EPI_QKV };
struct GA {
  const void* A; int lda; int ksplit; int koff2;
  const bf16_t* Bt; int K; int N; int MT; int m_base;
  const float* rss_in; int nparts; float* rss_out;
  const float* resid; float* xout; bf16_t* xb;
  bf16_t* outb;
  const float* c0; const float* c1; const float* c2;
  const float* pp; const bf16_t* auxb; bf16_t* aux2; const float* auxf;
};

template <int EPI, bool AF32>
DI void gemm_tile(const GA& g, int t, char* lds) {
  const int tid = tidx(), wv = tid >> 6, l = tid & 63, hl = l >> 5, lq = l & 31, wm = wv >> 1, wn = wv & 1;
  const int NT = g.N >> 7;
  const int x = t & 7, j = t >> 3, MTx = g.MT >> 3;
  const int mi = j & 7, j1 = j >> 3, nt = j1 % NT, mg = j1 / NT;
  const int mt = x * MTx + mg * 8 + mi;
  const int m0 = g.m_base + mt * 128, n0 = nt * 128;
  const int K = g.K, nk = K >> 6;
  f32x16 acc[2][2];
#pragma unroll
  for (int a = 0; a < 2; ++a)
#pragma unroll
    for (int b = 0; b < 2; ++b)
#pragma unroll
      for (int i = 0; i < 16; ++i) acc[a][b][i] = 0.f;
  u32x4 ra[4], rb[4];
  auto gload = [&](int kt) {
    const int k0 = kt << 6;
    const int acol = (k0 < g.ksplit) ? k0 : k0 + g.koff2;
#pragma unroll
    for (int i = 0; i < 4; ++i) {
      const int c = tid + 256 * i, row = c >> 3, kc = c & 7;
      if (AF32) {
        const float* ap = (const float*)g.A + (size_t)(m0 + row) * g.lda + acol + kc * 8;
        const f32x4 v0 = *(const f32x4*)ap, v1 = *(const f32x4*)(ap + 4);
        ra[i][0] = pack2(v0[0], v0[1]); ra[i][1] = pack2(v0[2], v0[3]); ra[i][2] = pack2(v1[0], v1[1]); ra[i][3] = pack2(v1[2], v1[3]);
      } else {
        ra[i] = *(const u32x4*)((const bf16_t*)g.A + (size_t)(m0 + row) * g.lda + acol + kc * 8);
      }
      rb[i] = *(const u32x4*)(g.Bt + (size_t)(n0 + row) * K + k0 + kc * 8);
    }
  };
  auto lstore = [&](int buf) {
    char* base = lds + buf * 32768;
#pragma unroll
    for (int i = 0; i < 4; ++i) {
      const int c = tid + 256 * i, row = c >> 3, kc = c & 7;
      const int off = row * 128 + ((kc ^ ((row >> 1) & 7)) << 4);
      *(u32x4*)(base + off) = ra[i];
      *(u32x4*)(base + 16384 + off) = rb[i];
    }
  };
  const int rowA0 = wm * 64 + lq, rowB0 = wn * 64 + lq;
  const int swA = (rowA0 >> 1) & 7, swB = (rowB0 >> 1) & 7;
  gload(0); lstore(0); __syncthreads();
  for (int kt = 0; kt < nk; ++kt) {
    if (kt + 1 < nk) gload(kt + 1);
    const char* Ab = lds + (kt & 1) * 32768; const char* Bb = Ab + 16384;
#pragma unroll
    for (int ks = 0; ks < 4; ++ks) {
      bf16x8 af[2], bfr[2];
#pragma unroll
      for (int f = 0; f < 2; ++f) {
        af[f] = *(const bf16x8*)(Ab + (rowA0 + f * 32) * 128 + (((ks * 2 + hl) ^ swA) << 4));
        bfr[f] = *(const bf16x8*)(Bb + (rowB0 + f * 32) * 128 + (((ks * 2 + hl) ^ swB) << 4));
      }
#pragma unroll
      for (int a = 0; a < 2; ++a)
#pragma unroll
        for (int b = 0; b < 2; ++b) acc[a][b] = MFMA32(af[a], bfr[b], acc[a][b]);
    }
    if (kt + 1 < nk) lstore((kt + 1) & 1);
    __syncthreads();
  }
  float* rs = (float*)(lds + 65536);
  if (EPI == EPI_WIN || EPI == EPI_UP || EPI == EPI_QKV || EPI == EPI_GATE) {
    if (tid < 128) {
      float s = 0.f;
      for (int q = 0; q < g.nparts; ++q) s += g.rss_in[(size_t)q * M + m0 + tid];
      rs[tid] = rsqrtf(s * (1.f / 1024.f) + 1e-6f);
    }
    __syncthreads();
  }
#pragma unroll
  for (int mf = 0; mf < 2; ++mf) {
#pragma unroll
    for (int i = 0; i < 16; ++i) {
      const int rl = wm * 64 + mf * 32 + (i & 3) + 8 * (i >> 2) + 4 * hl;
      const int row = m0 + rl;
      const int colb = n0 + wn * 64 + lq;
      float v0 = acc[mf][0][i], v1 = acc[mf][1][i];
      if (EPI == EPI_WIN) {
        const float r = rs[rl]; v0 *= r; v1 *= r;
        float o0, o1;
        if (n0 < 512 || (n0 >= 1536 && n0 < 2048)) { o0 = v0 * sigmoidf_(v0); o1 = v1 * sigmoidf_(v1); }
        else if (n0 < 1024) {
          const float lb0 = g.c0[colb - 512], lb1 = g.c0[colb + 32 - 512];
          o0 = logf(lb0 + (1.f - lb0) * sigmoidf_(v0)); o1 = logf(lb1 + (1.f - lb1) * sigmoidf_(v1));
        } else { o0 = v0; o1 = v1; }
        const bf16_t b0 = f2bf(o0), b1 = f2bf(o1);
        g.outb[(size_t)row * 3840 + colb] = b0; g.outb[(size_t)row * 3840 + colb + 32] = b1;
        if (n0 >= 2048 && (row & 15) == 15) { bf16_t* bd = g.aux2 + (size_t)(row >> 4) * 1792 + (colb - 2048); bd[0] = b0; bd[32] = b1; }
      } else if (EPI == EPI_LW) {
        float z0 = -(g.c0[colb] + v0), z1 = -(g.c0[colb + 32] + v1);
        const float sp0 = z0 > 20.f ? z0 : log1pf(expf(z0)), sp1 = z1 > 20.f ? z1 : log1pf(expf(z1));
        g.outb[(size_t)row * 512 + colb] = f2bf(-expf(-sp0 - 0.5f)); g.outb[(size_t)row * 512 + colb + 32] = f2bf(-expf(-sp1 - 0.5f));
      } else if (EPI == EPI_LA) {
        g.outb[(size_t)row * 512 + colb] = f2bf(sigmoidf_(g.c0[colb] + v0)); g.outb[(size_t)row * 512 + colb + 32] = f2bf(sigmoidf_(g.c0[colb + 32] + v1));
      } else if (EPI == EPI_POSTB) {
        const float y0 = bf2f(g.auxb[(size_t)row * 512 + colb]), y1 = bf2f(g.auxb[(size_t)row * 512 + colb + 32]);
        const float s1 = allreduce32(y0 + y1) * (1.f / 64.f);
        const float d0 = y0 - s1, d1 = y1 - s1;
        const float var = allreduce32(d0 * d0 + d1 * d1) * (1.f / 64.f);
        const float rstd = rsqrtf(var + 64e-5f);
        const int head = (n0 >> 6) + wn;
        const float bon = g.auxf[(size_t)row * 8 + head];
        bf16_t* ur = g.outb + (size_t)row * 3840 + 2048;
        const float vv0 = bf2f(ur[1024 + colb]), vv1 = bf2f(ur[1024 + colb + 32]);
        const float o0 = (d0 * rstd * g.c0[colb] + g.c1[colb] + bon * vv0) * v0;
        const float o1 = (d1 * rstd * g.c0[colb + 32] + g.c1[colb + 32] + bon * vv1) * v1;
        ur[colb] = f2bf(o0); ur[colb + 32] = f2bf(o1);
      } else if (EPI == EPI_RES || EPI == EPI_GATE) {
        const size_t o = (size_t)row * 1024 + colb;
        float x0, x1;
        if (EPI == EPI_RES) { x0 = g.resid[o] + v0; x1 = g.resid[o + 32] + v1; }
        else {
          const float r = rs[rl];
          x0 = g.resid[o] + g.pp[o] * r * g.c0[colb] * sigmoidf_(v0);
          x1 = g.resid[o + 32] + g.pp[o + 32] * r * g.c0[colb + 32] * sigmoidf_(v1);
        }
        g.xout[o] = x0; g.xout[o + 32] = x1;
        g.xb[o] = f2bf(x0); g.xb[o + 32] = f2bf(x1);
        const float ss = allreduce32(x0 * x0 + x1 * x1);
        if (lq == 0) g.rss_out[(size_t)(nt * 2 + wn) * M + row] = ss;
      } else if (EPI == EPI_UP) {
        const float r = rs[rl];
        float a0 = fmaxf(v0 * r, 0.f), a1 = fmaxf(v1 * r, 0.f);
        g.outb[(size_t)row * 4096 + colb] = f2bf(a0 * a0); g.outb[(size_t)row * 4096 + colb + 32] = f2bf(a1 * a1);
      } else if (EPI == EPI_PP) {
        const size_t o = (size_t)row * 1024 + colb;
        g.xout[o] = v0; g.xout[o + 32] = v1;
        const float ss = allreduce32(v0 * v0 + v1 * v1);
        if (lq == 0) g.rss_out[(size_t)(nt * 2 + wn) * M + row] = ss;
      } else if (EPI == EPI_QKV) {
        const float r = rs[rl];
        g.outb[(size_t)row * 3072 + colb] = f2bf(v0 * r); g.outb[(size_t)row * 3072 + colb + 32] = f2bf(v1 * r);
      }
    }
  }
}

struct TJob { const float* src; bf16_t* dst; const float* gain; int K, N; };
DI void transpose_unit(const TJob& j, int unit, char* ldsc) {
  float* lds = (float*)ldsc;
  const int tid = tidx();
  const int nkt = j.K >> 6, kt = unit % nkt, nt = unit / nkt;
#pragma unroll
  for (int i = 0; i < 4; ++i) {
    const int r = (tid >> 4) + 16 * i, c4 = (tid & 15) * 4, k = kt * 64 + r;
    const f32x4 v = *(const f32x4*)(j.src + (size_t)k * j.N + nt * 64 + c4);
    const float gn = j.gain ? j.gain[k] : 1.f;
    lds[r * 65 + c4] = v[0] * gn; lds[r * 65 + c4 + 1] = v[1] * gn; lds[r * 65 + c4 + 2] = v[2] * gn; lds[r * 65 + c4 + 3] = v[3] * gn;
  }
  __syncthreads();
#pragma unroll
  for (int i = 0; i < 2; ++i) {
    const int n = (tid >> 3) + 32 * i, k8 = (tid & 7) * 8;
    u32x4 o;
    o[0] = pack2(lds[(k8 + 0) * 65 + n], lds[(k8 + 1) * 65 + n]); o[1] = pack2(lds[(k8 + 2) * 65 + n], lds[(k8 + 3) * 65 + n]);
    o[2] = pack2(lds[(k8 + 4) * 65 + n], lds[(k8 + 5) * 65 + n]); o[3] = pack2(lds[(k8 + 6) * 65 + n], lds[(k8 + 7) * 65 + n]);
    *(u32x4*)(j.dst + (size_t)(nt * 64 + n) * j.K + kt * 64 + k8) = o;
  }
  __syncthreads();
}
#define TJ(SRC, DST, GAIN, KK, NN) { const int n_ = ((KK) >> 6) * ((NN) >> 6); if (uu < n_) { TJob j_; j_.src = (SRC); j_.dst = (bf16_t*)(DST); j_.gain = (GAIN); j_.K = (KK); j_.N = (NN); transpose_unit(j_, uu, lds); return; } uu -= n_; }
DI void tjobs0(const Pm& p, int uu, char* lds) {
  char* ws = p.ws;
  TJ(p.in[4], ws + W_WIN, p.in[2], 1024, 3840)
  TJ(p.in[5], ws + W_WOUT, nullptr, 1024, 1024)
  TJ(p.in[23], ws + W_UP0, p.in[3], 1024, 4096)
  TJ(p.in[24], ws + W_DN0, nullptr, 4096, 1024)
  TJ(p.in[25], ws + W_PPJ0, nullptr, 256, 1024)
  TJ(p.in[27], ws + W_PGT0, nullptr, 1024, 1024)
  TJ(p.in[10], ws + W_W2, nullptr, 64, 512)
  TJ(p.in[12], ws + W_A2, nullptr, 64, 512)
  TJ(p.in[13], ws + W_G2, nullptr, 128, 512)
}
DI void tjobs1(const Pm& p, int uu, char* lds) {
  char* ws = p.ws;
  TJ(p.in[19], ws + W_QKV, p.in[2] + 1024, 1024, 3072)
  TJ(p.in[20], ws + W_WO, nullptr, 1024, 1024)
  TJ(p.in[23] + (size_t)1024 * 4096, ws + W_UP1, p.in[3] + 1024, 1024, 4096)
  TJ(p.in[24] + (size_t)4096 * 1024, ws + W_DN1, nullptr, 4096, 1024)
  TJ(p.in[25] + (size_t)256 * 1024, ws + W_PPJ1, nullptr, 256, 1024)
  TJ(p.in[27] + (size_t)1024 * 1024, ws + W_PGT1, nullptr, 1024, 1024)
}
DI void phase0(const Pm& p, char* lds) {
  char* ws = p.ws;
  constexpr int NT_UNITS = 960 + 256 + 1024 + 1024 + 64 + 256 + 8 + 8 + 16;
  constexpr int NX_UNITS = 256;
  const int total = NT_UNITS + NX_UNITS + 1;
  const int tid = tidx(), wv = tid >> 6, l = tid & 63;
  for (int u = blockIdx.x; u < total; u += gridDim.x) {
    if (u < NT_UNITS) { tjobs0(p, u, lds); }
    else if (u < NT_UNITS + NX_UNITS) {
      const int r0 = (u - NT_UNITS) * 64 + wv * 16;
      const float* x = p.in[0]; bf16_t* xb = (bf16_t*)(ws + XB_A); float* rss = (float*)(ws + RSS_X0);
      for (int r = r0; r < r0 + 16; ++r) {
        float ss = 0.f;
#pragma unroll
        for (int q = 0; q < 4; ++q) {
          const f32x4 v = *(const f32x4*)(x + (size_t)r * 1024 + q * 256 + l * 4);
          ss += v[0] * v[0] + v[1] * v[1] + v[2] * v[2] + v[3] * v[3];
          u32x2 o; o[0] = pack2(v[0], v[1]); o[1] = pack2(v[2], v[3]);
          *(u32x2*)(xb + (size_t)r * 1024 + q * 256 + l * 4) = o;
        }
        ss = allreduce64(ss);
        if (l == 0) rss[r] = ss;
      }
    } else {
      const float* hl = p.in[6]; float* lb = (float*)(ws + LBOFF);
      for (int c = tid; c < 512; c += 256) {
        const float a0 = hl[c], a1 = hl[512 + c], a2 = hl[1024 + c];
        const float mx = fmaxf(a0, fmaxf(a1, a2));
        const float e0 = expf(a0 - mx), e1 = expf(a1 - mx), e2 = expf(a2 - mx);
        lb[c] = e0 / (e0 + e1 + e2);
      }
    }
  }
}

DI void phase_w1_unit(const Pm& p, int u, char* lds) {
  char* ws = p.ws;
  constexpr int NT_UNITS = 768 + 256 + 1024 + 1024 + 64 + 256;
  if (u < NT_UNITS) { tjobs1(p, u, lds); }
  else {
    const int idx0 = (u - NT_UNITS) * 256 + tidx();
    const int s = idx0 >> 6, i = idx0 & 63;
    const float inv_freq = powf(10000.f, -(float)i / 64.f);
    const float ang = (float)s * inv_freq;
    float2 cs; cs.x = (float)cos((double)ang); cs.y = (float)sin((double)ang);
    ((float2*)(ws + ROPE))[idx0] = cs;
  }
}
constexpr int W1_UNITS = 3392 + 1024;

DI void tokshift_unit(const Pm& p, int tile) {
  char* ws = p.ws;
  const int l = tidx() & 63;
  bf16_t* U = (bf16_t*)(ws + U_OFF);
  const bf16_t* bnd = (const bf16_t*)(ws + BND);
  const float* mu = p.in[8];
  const int t0 = tile * 16;
  u32x2 cur[7], prv[7];
#pragma unroll
  for (int j = 0; j < 7; ++j) cur[j] = *(const u32x2*)(U + (size_t)(t0 + 15) * 3840 + 2048 + j * 256 + l * 4);
  for (int r = 15; r >= 0; --r) {
    const bool zero = (r == 0) && ((t0 & 4095) == 0);
    const bf16_t* pr = (r > 0) ? (U + (size_t)(t0 + r - 1) * 3840 + 2048) : (bnd + (size_t)(tile - 1) * 1792);
#pragma unroll
    for (int j = 0; j < 7; ++j) { if (zero) { prv[j][0] = 0; prv[j][1] = 0; } else prv[j] = *(const u32x2*)(pr + j * 256 + l * 4); }
#pragma unroll
    for (int j = 0; j < 7; ++j) {
      const int c = j * 256 + l * 4;
      const f32x4 m = *(const f32x4*)(mu + c);
      float o[4];
      o[0] = lo16(cur[j][0]); o[1] = hi16(cur[j][0]); o[2] = lo16(cur[j][1]); o[3] = hi16(cur[j][1]);
      const float q0 = lo16(prv[j][0]), q1 = hi16(prv[j][0]), q2 = lo16(prv[j][1]), q3 = hi16(prv[j][1]);
      o[0] += (q0 - o[0]) * m[0]; o[1] += (q1 - o[1]) * m[1]; o[2] += (q2 - o[2]) * m[2]; o[3] += (q3 - o[3]) * m[3];
      if (j == 6) {
        if (l < 16) { for (int e = 0; e < 4; ++e) o[e] = tanhf(o[e]); }
        else if (l >= 32) { for (int e = 0; e < 4; ++e) o[e] = sigmoidf_(o[e]); }
      }
      u32x2 w; w[0] = pack2(o[0], o[1]); w[1] = pack2(o[2], o[3]);
      *(u32x2*)(U + (size_t)(t0 + r) * 3840 + 2048 + c) = w;
      cur[j] = prv[j];
    }
  }
}

DI void rwkv_unit(const Pm& p, int u, char* lds) {
  char* ws = p.ws;
  const int bh = u & 31, qtr = u >> 5, b = bh >> 3, h = bh & 7;
  const int tid = tidx(), wv = tid >> 6, l = tid & 63, rg = l >> 4, c = l & 15;
  const int row = qtr * 16 + wv * 4 + rg;
  const int tk = tid >> 4, cg = tid & 15, hc = h * 64 + cg * 4;
  const bf16_t* U = (const bf16_t*)(ws + U_OFF);
  const bf16_t* AA = (const bf16_t*)(ws + AARR);
  const bf16_t* LD = (const bf16_t*)(ws + LOGD);
  bf16_t* Y = (bf16_t*)(ws + Y_OFF);
  float* bonus = (float*)(ws + BONUS);
  const f32x4 kkc = *(const f32x4*)(p.in[14] + hc), kac = *(const f32x4*)(p.in[15] + hc), rkc = *(const f32x4*)(p.in[16] + hc);
  float S0 = 0.f, S1 = 0.f, S2 = 0.f, S3 = 0.f;
  u32x2 gr, gk, gv, ga, gl;
  auto gload = [&](int ch) {
    const size_t tok = (size_t)b * 4096 + ch * 16 + tk;
    const bf16_t* up = U + tok * 3840 + 2048 + hc;
    gr = *(const u32x2*)up; gk = *(const u32x2*)(up + 512); gv = *(const u32x2*)(up + 1024);
    ga = *(const u32x2*)(AA + tok * 512 + hc); gl = *(const u32x2*)(LD + tok * 512 + hc);
  };
  auto stage = [&](int ch, int buf) {
    char* base = lds + buf * 24576 + tk * 256 + cg * 16;
    f32x4 r, k, v, a, ld;
    r[0] = lo16(gr[0]); r[1] = hi16(gr[0]); r[2] = lo16(gr[1]); r[3] = hi16(gr[1]);
    k[0] = lo16(gk[0]); k[1] = hi16(gk[0]); k[2] = lo16(gk[1]); k[3] = hi16(gk[1]);
    v[0] = lo16(gv[0]); v[1] = hi16(gv[0]); v[2] = lo16(gv[1]); v[3] = hi16(gv[1]);
    a[0] = lo16(ga[0]); a[1] = hi16(ga[0]); a[2] = lo16(ga[1]); a[3] = hi16(ga[1]);
    ld[0] = lo16(gl[0]); ld[1] = hi16(gl[0]); ld[2] = lo16(gl[1]); ld[3] = hi16(gl[1]);
    f32x4 kx, kk, kf, kka, w;
    float ss = 0.f, bon = 0.f;
#pragma unroll
    for (int e = 0; e < 4; ++e) { kx[e] = k[e] * kkc[e]; ss += kx[e] * kx[e]; }
    ss = allreduce16(ss);
    const float inv = 1.f / fmaxf(sqrtf(ss), 1e-12f);
#pragma unroll
    for (int e = 0; e < 4; ++e) {
      kk[e] = kx[e] * inv; kf[e] = k[e] * (1.f + (a[e] - 1.f) * kac[e]); kka[e] = kk[e] * a[e]; w[e] = __expf(ld[e]);
      bon += r[e] * kf[e] * rkc[e];
    }
    bon = allreduce16(bon);
    if (qtr == 0 && cg == 0) bonus[((size_t)b * 4096 + ch * 16 + tk) * 8 + h] = bon;
    *(f32x4*)(base) = w; *(f32x4*)(base + 4096) = kk; *(f32x4*)(base + 8192) = kka; *(f32x4*)(base + 12288) = kf; *(f32x4*)(base + 16384) = r; *(f32x4*)(base + 20480) = v;
  };
  gload(0); stage(0, 0); __syncthreads();
  for (int ch = 0; ch < 256; ++ch) {
    if (ch + 1 < 256) gload(ch + 1);
    const char* base = lds + (ch & 1) * 24576;
    float ykeep = 0.f;
#pragma unroll
    for (int s = 0; s < 16; ++s) {
      const char* bs = base + s * 256 + c * 16;
      const f32x4 w = *(const f32x4*)(bs), kk = *(const f32x4*)(bs + 4096), kka = *(const f32x4*)(bs + 8192), k = *(const f32x4*)(bs + 12288), r = *(const f32x4*)(bs + 16384);
      const float v = *(const float*)(base + 20480 + s * 256 + row * 4);
      float d = S0 * kk[0] + S1 * kk[1] + S2 * kk[2] + S3 * kk[3];
      d = allreduce16(d);
      const float sa = -d;
      S0 = S0 * w[0] + sa * kka[0] + v * k[0]; S1 = S1 * w[1] + sa * kka[1] + v * k[1];
      S2 = S2 * w[2] + sa * kka[2] + v * k[2]; S3 = S3 * w[3] + sa * kka[3] + v * k[3];
      float y = S0 * r[0] + S1 * r[1] + S2 * r[2] + S3 * r[3];
      y = allreduce16(y);
      if (c == s) ykeep = y;
    }
    Y[((size_t)b * 4096 + ch * 16 + c) * 512 + h * 64 + row] = f2bf(ykeep);
    if (ch + 1 < 256) stage(ch + 1, (ch + 1) & 1);
    __syncthreads();
  }
}

DI void hgrn_unit(const Pm& p, int u, char* lds) {
  char* ws = p.ws;
  const int bh = u & 15, vs = u >> 4, b = bh >> 2, h = bh & 3;
  const int tid = tidx(), wv = tid >> 6, l = tid & 63, rg = l >> 4, c = l & 15;
  const int vcol = wv * 4 + rg;
  const int tk = tid >> 4, cg = tid & 15;
  const bf16_t* U = (const bf16_t*)(ws + U_OFF);
  bf16_t* OA = (bf16_t*)(ws + OA_OFF);
  float S[8];
#pragma unroll
  for (int e = 0; e < 8; ++e) S[e] = 0.f;
  u32x4 gq, gf; bf16_t gvv;
  auto gload = [&](int ch) {
    const size_t tok = (size_t)b * 4096 + ch * 16 + tk;
    const bf16_t* up = U + tok * 3840 + h * 128;
    gq = *(const u32x4*)(up + cg * 8); gf = *(const u32x4*)(up + 512 + cg * 8); gvv = up[1024 + vs * 16 + cg];
  };
  auto stage = [&](int buf) {
    char* base = lds + buf * 25600;
    f32x4 f0, f1, k0, k1, q0, q1;
#pragma unroll
    for (int e = 0; e < 2; ++e) {
      f0[2 * e] = __expf(lo16(gf[e])); f0[2 * e + 1] = __expf(hi16(gf[e])); f1[2 * e] = __expf(lo16(gf[2 + e])); f1[2 * e + 1] = __expf(hi16(gf[2 + e]));
      q0[2 * e] = lo16(gq[e]); q0[2 * e + 1] = hi16(gq[e]); q1[2 * e] = lo16(gq[2 + e]); q1[2 * e + 1] = hi16(gq[2 + e]);
    }
#pragma unroll
    for (int e = 0; e < 4; ++e) { k0[e] = 1.f - f0[e]; k1[e] = 1.f - f1[e]; }
    char* w = base + tk * 512 + cg * 32;
    *(f32x4*)(w) = f0; *(f32x4*)(w + 16) = f1; *(f32x4*)(w + 8192) = k0; *(f32x4*)(w + 8192 + 16) = k1; *(f32x4*)(w + 16384) = q0; *(f32x4*)(w + 16384 + 16) = q1;
    *(float*)(base + 24576 + tk * 64 + cg * 4) = bf2f(gvv);
  };
  gload(0); stage(0); __syncthreads();
  for (int ch = 0; ch < 256; ++ch) {
    if (ch + 1 < 256) gload(ch + 1);
    const char* base = lds + (ch & 1) * 25600;
    float ykeep = 0.f;
#pragma unroll
    for (int s = 0; s < 16; ++s) {
      const char* bs = base + s * 512 + c * 16;
      const f32x4 f0 = *(const f32x4*)(bs), f1 = *(const f32x4*)(bs + 256), k0 = *(const f32x4*)(bs + 8192), k1 = *(const f32x4*)(bs + 8192 + 256), q0 = *(const f32x4*)(bs + 16384), q1 = *(const f32x4*)(bs + 16384 + 256);
      const float v = *(const float*)(base + 24576 + s * 64 + vcol * 4);
      float a0 = 0.f, a1 = 0.f;
#pragma unroll
      for (int e = 0; e < 4; ++e) {
        S[e] = f0[e] * S[e] + k0[e] * v; a0 += S[e] * q0[e];
        S[4 + e] = f1[e] * S[4 + e] + k1[e] * v; a1 += S[4 + e] * q1[e];
      }
      const float y = allreduce16(a0 + a1);
      if (c == s) ykeep = y;
    }
    OA[((size_t)b * 4096 + ch * 16 + c) * 512 + h * 128 + vs * 16 + vcol] = f2bf(ykeep);
    if (ch + 1 < 256) stage((ch + 1) & 1);
    __syncthreads();
  }
}

DI void oapost_unit(const Pm& p, int unit) {
  char* ws = p.ws;
  const int wv = tidx() >> 6, l = tidx() & 63;
  const bf16_t* OA = (const bf16_t*)(ws + OA_OFF);
  bf16_t* U = (bf16_t*)(ws + U_OFF);
  const float* on = p.in[7] + l * 8;
  const f32x4 g0 = *(const f32x4*)on, g1 = *(const f32x4*)(on + 4);
  for (int r = 0; r < 16; ++r) {
    const size_t tok = (size_t)unit * 64 + wv * 16 + r;
    const u32x4 o = *(const u32x4*)(OA + tok * 512 + l * 8);
    const u32x4 hg = *(const u32x4*)(U + tok * 3840 + 1536 + l * 8);
    float v[8], gt[8];
#pragma unroll
    for (int e = 0; e < 4; ++e) { v[2 * e] = lo16(o[e]); v[2 * e + 1] = hi16(o[e]); gt[2 * e] = lo16(hg[e]); gt[2 * e + 1] = hi16(hg[e]); }
    float ss = 0.f;
#pragma unroll
    for (int e = 0; e < 8; ++e) ss += v[e] * v[e];
    ss = allreduce16(ss);
    const float inv = rsqrtf(ss * (1.f / 128.f) + 1e-6f);
    u32x4 w;
    w[0] = pack2(v[0] * inv * g0[0] * gt[0], v[1] * inv * g0[1] * gt[1]); w[1] = pack2(v[2] * inv * g0[2] * gt[2], v[3] * inv * g0[3] * gt[3]);
    w[2] = pack2(v[4] * inv * g1[0] * gt[4], v[5] * inv * g1[1] * gt[5]); w[3] = pack2(v[6] * inv * g1[2] * gt[6], v[7] * inv * g1[3] * gt[7]);
    *(u32x4*)(U + tok * 3840 + l * 8) = w;
  }
}

DI void attnprep_unit(const Pm& p, int unit, char* lds) {
  char* ws = p.ws;
  const int bh = unit & 31, blk = unit >> 5, b = bh >> 3, h = bh & 7;
  const int tid = tidx(), wv = tid >> 6, l = tid & 63;
  bf16_t* qkv = (bf16_t*)(ws + QKV);
  bf16_t* vt = (bf16_t*)(ws + VT);
  float* kmean = (float*)(ws + KMEAN);
  const float2* rope = (const float2*)(ws + ROPE);
  const float gq0 = p.in[21][l], gq1 = p.in[21][l + 64], gk0 = p.in[22][l], gk1 = p.in[22][l + 64];
  float ks0 = 0.f, ks1 = 0.f;
  for (int it = 0; it < 64; ++it) {
    const int s = blk * 256 + wv * 64 + it;
    const size_t rowo = ((size_t)b * 4096 + s) * 3072;
    const float2 cs = rope[s * 64 + l];
    {
      bf16_t* qp = qkv + rowo + h * 128;
      float x0 = bf2f(qp[l]), x1 = bf2f(qp[l + 64]);
      const float ss = allreduce64(x0 * x0 + x1 * x1);
      const float inv = rsqrtf(ss * (1.f / 128.f) + 1e-6f);
      x0 *= inv * gq0; x1 *= inv * gq1;
      const float o0 = x0 * cs.x - x1 * cs.y, o1 = x1 * cs.x + x0 * cs.y;
      qp[l] = f2bf(o0 * QSCALE); qp[l + 64] = f2bf(o1 * QSCALE);
    }
    {
      bf16_t* kp = qkv + rowo + 1024 + h * 128;
      float x0 = bf2f(kp[l]), x1 = bf2f(kp[l + 64]);
      const float ss = allreduce64(x0 * x0 + x1 * x1);
      const float inv = rsqrtf(ss * (1.f / 128.f) + 1e-6f);
      x0 *= inv * gk0; x1 *= inv * gk1;
      const float o0 = x0 * cs.x - x1 * cs.y, o1 = x1 * cs.x + x0 * cs.y;
      ks0 += o0; ks1 += o1;
      kp[l] = f2bf(o0); kp[l + 64] = f2bf(o1);
    }
  }
  float* red = (float*)lds;
  red[wv * 128 + l] = ks0; red[wv * 128 + 64 + l] = ks1;
  __syncthreads();
  if (tid < 128) kmean[((size_t)bh * 16 + blk) * 128 + tid] = (red[tid] + red[128 + tid] + red[256 + tid] + red[384 + tid]) * (1.f / 256.f);
  __syncthreads();
  for (int st = 0; st < 4; ++st) {
    const size_t tokbase = (size_t)b * 4096 + blk * 256 + st * 64;
#pragma unroll
    for (int i = 0; i < 4; ++i) {
      const int c = tid + 256 * i, r = c >> 4, ch = c & 15;
      *(u32x4*)(lds + r * 272 + ch * 16) = *(const u32x4*)(qkv + (tokbase + r) * 3072 + 2048 + h * 128 + ch * 8);
    }
    __syncthreads();
#pragma unroll
    for (int i = 0; i < 4; ++i) {
      const int d = tid & 127, t8 = (tid >> 7) + 2 * i;
      unsigned short e[8];
#pragma unroll
      for (int j = 0; j < 8; ++j) e[j] = *(const unsigned short*)(lds + (t8 * 8 + j) * 272 + d * 2);
      u32x4 o;
      o[0] = e[0] | ((unsigned)e[1] << 16); o[1] = e[2] | ((unsigned)e[3] << 16); o[2] = e[4] | ((unsigned)e[5] << 16); o[3] = e[6] | ((unsigned)e[7] << 16);
      *(u32x4*)(vt + ((size_t)bh * 128 + d) * 4096 + blk * 256 + st * 64 + t8 * 8) = o;
    }
    __syncthreads();
  }
}

DI void attn_unit(const Pm& p, int unit, char* lds) {
  char* ws = p.ws;
  const int qt = 31 - (unit >> 5), bh = unit & 31, b = bh >> 3, h = bh & 7;
  const int tid = tidx(), wv = tid >> 6, l = tid & 63, hl = l >> 5, lq = l & 31;
  const int qb = qt >> 1;
  const size_t tok0 = (size_t)b * 4096 + qt * 128;
  const int myq = qt * 128 + wv * 32 + lq;
  bf16_t* qkv = (bf16_t*)(ws + QKV);
  const bf16_t* vt = (const bf16_t*)(ws + VT);
  const float* kmean = (const float*)(ws + KMEAN);
  const float NEG = -__builtin_inff();
  bf16x8 qf[8];
  {
    const bf16_t* qp = qkv + (tok0 + wv * 32 + lq) * 3072 + h * 128 + hl * 8;
#pragma unroll
    for (int ks = 0; ks < 8; ++ks) qf[ks] = *(const bf16x8*)(qp + ks * 16);
  }
  unsigned selmask = 0;
  unsigned* bm = (unsigned*)(lds + 65536 + 512);
  if (tid == 0) *bm = 0;
  if (qb > 0) {
    float* km = (float*)lds;
    for (int i = tid; i < qb * 128; i += 256) km[i] = kmean[(size_t)bh * 16 * 128 + i];
    __syncthreads();
    if (qb <= 3) selmask = (1u << qb) - 1u;
    else {
      float b0 = NEG, b1 = NEG, b2 = NEG; int i0 = 0, i1 = 0, i2 = 0;
      for (int n = 0; n < qb; ++n) {
        float gsum = 0.f;
#pragma unroll
        for (int ks = 0; ks < 8; ++ks) {
          const float* kr = km + n * 128 + ks * 16 + hl * 8;
#pragma unroll
          for (int j = 0; j < 8; ++j) gsum += bf2f((bf16_t)qf[ks][j]) * kr[j];
        }
        gsum += __shfl_xor(gsum, 32);
        if (gsum > b0) { b2 = b1; i2 = i1; b1 = b0; i1 = i0; b0 = gsum; i0 = n; }
        else if (gsum > b1) { b2 = b1; i2 = i1; b1 = gsum; i1 = n; }
        else if (gsum > b2) { b2 = gsum; i2 = n; }
      }
      selmask = (1u << i0) | (1u << i1) | (1u << i2);
    }
  }
  __syncthreads();
  if (selmask) atomicOr(bm, selmask);
  __syncthreads();
  const unsigned blkmask = *bm;
  const int own_tiles = (qt & 1) ? 4 : 2;
  int n = 0, kt = 0;
  while (n < qb && !((blkmask >> n) & 1u)) ++n;
  u32x4 rk[4], rv[4];
  auto gload = [&](int nn, int kk) {
    const int key0 = nn * 256 + kk * 64;
#pragma unroll
    for (int i = 0; i < 4; ++i) {
      const int c = tid + 256 * i;
      rk[i] = *(const u32x4*)(qkv + ((size_t)b * 4096 + key0 + (c >> 4)) * 3072 + 1024 + h * 128 + (c & 15) * 8);
      rv[i] = *(const u32x4*)(vt + ((size_t)bh * 128 + (c >> 3)) * 4096 + key0 + (c & 7) * 8);
    }
  };
  auto lstore = [&](int buf) {
    char* base = lds + buf * 32768;
#pragma unroll
    for (int i = 0; i < 4; ++i) {
      const int c = tid + 256 * i;
      const int r = c >> 4, ch = c & 15;
      *(u32x4*)(base + r * 256 + ((ch ^ (r & 15)) << 4)) = rk[i];
      const int d = c >> 3, cv = c & 7;
      *(u32x4*)(base + 16384 + d * 128 + ((cv ^ ((d >> 1) & 7)) << 4)) = rv[i];
    }
  };
  f32x16 oacc[4];
#pragma unroll
  for (int a = 0; a < 4; ++a)
#pragma unroll
    for (int i = 0; i < 16; ++i) oacc[a][i] = 0.f;
  float m_run = NEG, l_run = 0.f;
  gload(n, kt); lstore(0); __syncthreads();
  int st = 0;
  while (n <= qb) {
    int n2 = n, kt2 = kt + 1;
    if (kt2 >= ((n == qb) ? own_tiles : 4)) { kt2 = 0; ++n2; while (n2 < qb && !((blkmask >> n2) & 1u)) ++n2; }
    const bool has_next = (n2 <= qb);
    if (has_next) gload(n2, kt2);
    const char* Kb = lds + st * 32768; const char* Vb = Kb + 16384;
    f32x16 sacc[2];
#pragma unroll
    for (int mf = 0; mf < 2; ++mf) {
#pragma unroll
      for (int i = 0; i < 16; ++i) sacc[mf][i] = 0.f;
      const int krow = mf * 32 + lq;
#pragma unroll
      for (int ks = 0; ks < 8; ++ks) {
        const bf16x8 a = *(const bf16x8*)(Kb + krow * 256 + (((ks * 2 + hl) ^ (krow & 15)) << 4));
        sacc[mf] = MFMA32(a, qf[ks], sacc[mf]);
      }
    }
    if (n == qb) {
      const int key0 = n * 256 + kt * 64;
#pragma unroll
      for (int mf = 0; mf < 2; ++mf)
#pragma unroll
        for (int i = 0; i < 16; ++i) { const int kp = key0 + mf * 32 + (i & 3) + 8 * (i >> 2) + 4 * hl; if (kp > myq) sacc[mf][i] = NEG; }
    } else if (!((selmask >> n) & 1u)) {
#pragma unroll
      for (int mf = 0; mf < 2; ++mf)
#pragma unroll
        for (int i = 0; i < 16; ++i) sacc[mf][i] = NEG;
    }
    float mt = NEG;
#pragma unroll
    for (int mf = 0; mf < 2; ++mf)
#pragma unroll
      for (int i = 0; i < 16; ++i) mt = fmaxf(mt, sacc[mf][i]);
    mt = fmaxf(mt, __shfl_xor(mt, 32));
    const float mnew = fmaxf(m_run, mt);
    const float muse = (mnew == NEG) ? 0.f : mnew;
    const float alpha = __builtin_amdgcn_exp2f(m_run - muse);
    m_run = mnew;
    float psum = 0.f;
#pragma unroll
    for (int mf = 0; mf < 2; ++mf)
#pragma unroll
      for (int i = 0; i < 16; ++i) { const float pe = __builtin_amdgcn_exp2f(sacc[mf][i] - muse); sacc[mf][i] = pe; psum += pe; }
    l_run = l_run * alpha + psum;
#pragma unroll
    for (int a = 0; a < 4; ++a)
#pragma unroll
      for (int i = 0; i < 16; ++i) oacc[a][i] *= alpha;
    bf16x8 pf[2][2];
#pragma unroll
    for (int mf = 0; mf < 2; ++mf)
#pragma unroll
      for (int s2 = 0; s2 < 2; ++s2) {
        u32x4 pk;
#pragma unroll
        for (int e = 0; e < 4; ++e) pk[e] = pack2(sacc[mf][8 * s2 + 2 * e], sacc[mf][8 * s2 + 2 * e + 1]);
        pf[mf][s2] = __builtin_bit_cast(bf16x8, pk);
      }
#pragma unroll
    for (int md = 0; md < 4; ++md) {
      const int drow = md * 32 + lq, sw = (drow >> 1) & 7;
#pragma unroll
      for (int mf = 0; mf < 2; ++mf)
#pragma unroll
        for (int s2 = 0; s2 < 2; ++s2) {
          const int chunk = 4 * mf + 2 * s2;
          const bf16x4 lo = *(const bf16x4*)(Vb + drow * 128 + ((chunk ^ sw) << 4) + 8 * hl);
          const bf16x4 hi = *(const bf16x4*)(Vb + drow * 128 + (((chunk + 1) ^ sw) << 4) + 8 * hl);
          const bf16x8 a = __builtin_shufflevector(lo, hi, 0, 1, 2, 3, 4, 5, 6, 7);
          oacc[md] = MFMA32(a, pf[mf][s2], oacc[md]);
        }
    }
    if (has_next) lstore(st ^ 1);
    __syncthreads();
    n = n2; kt = kt2; st ^= 1;
  }
  const float ltot = l_run + __shfl_xor(l_run, 32);
  const float inv = 1.f / ltot;
  bf16_t* op = qkv + (tok0 + wv * 32 + lq) * 3072 + h * 128;
#pragma unroll
  for (int md = 0; md < 4; ++md)
#pragma unroll
    for (int i4 = 0; i4 < 4; ++i4) {
      u32x2 o; o[0] = pack2(oacc[md][4 * i4] * inv, oacc[md][4 * i4 + 1] * inv); o[1] = pack2(oacc[md][4 * i4 + 2] * inv, oacc[md][4 * i4 + 3] * inv);
      *(u32x2*)(op + md * 32 + 8 * i4 + 4 * hl) = o;
    }
  __syncthreads();
}

constexpr int NPHASE = 21;

DI GA ga_zero() { GA g; g.A = nullptr; g.lda = 0; g.ksplit = 1 << 30; g.koff2 = 0; g.Bt = nullptr; g.K = 0; g.N = 0; g.MT = 128; g.m_base = 0; g.rss_in = nullptr; g.nparts = 0; g.rss_out = nullptr;
  g.resid = nullptr; g.xout = nullptr; g.xb = nullptr; g.outb = nullptr; g.c0 = nullptr; g.c1 = nullptr; g.c2 = nullptr; g.pp = nullptr; g.auxb = nullptr; g.aux2 = nullptr; g.auxf = nullptr; return g; }

template <int EPI, bool AF32>
DI void run_gemm(const GA& g, char* lds) {
  const int total = g.MT * (g.N >> 7);
  for (int t = blockIdx.x; t < total; t += gridDim.x) gemm_tile<EPI, AF32>(g, t, lds);
}

DI void mlp_phase(const Pm& p, int layer, int sub, char* lds) {
  char* ws = p.ws;
  const bf16_t* xin = (const bf16_t*)(ws + (layer == 0 ? XB_A : XB_B));
  bf16_t* xmid = (bf16_t*)(ws + (layer == 0 ? XB_B : XB_A));
  bf16_t* xnext = (bf16_t*)(ws + (layer == 0 ? XB_A : XB_B));
  const float* rss_in = (const float*)(ws + (layer == 0 ? RSS_A : RSS_B));
  float* rss_mid = (float*)(ws + (layer == 0 ? RSS_B : RSS_A));
  float* rss_next = (float*)(ws + (layer == 0 ? RSS_A : RSS_B));
  const bf16_t* wup = (const bf16_t*)(ws + (layer == 0 ? W_UP0 : W_UP1));
  const bf16_t* wdn = (const bf16_t*)(ws + (layer == 0 ? W_DN0 : W_DN1));
  const bf16_t* wpj = (const bf16_t*)(ws + (layer == 0 ? W_PPJ0 : W_PPJ1));
  const bf16_t* wgt = (const bf16_t*)(ws + (layer == 0 ? W_PGT0 : W_PGT1));
  if (sub == 0 || sub == 2) {
    const int mb = (sub == 0) ? 0 : 8192;
    GA g = ga_zero(); g.A = xin; g.lda = 1024; g.Bt = wup; g.K = 1024; g.N = 4096; g.MT = 64; g.m_base = mb;
    g.rss_in = rss_in; g.nparts = 16; g.outb = (bf16_t*)(ws + ACT) - (size_t)mb * 4096;
    const int n_up = 64 * 32;
    if (sub == 0) {
      GA q = ga_zero(); q.A = p.in[1] + (size_t)layer * M * 256; q.lda = 256; q.Bt = wpj; q.K = 256; q.N = 1024; q.MT = 128;
      q.xout = (float*)(ws + PPB); q.rss_out = (float*)(ws + RSS_P);
      const int n_pp = 128 * 8;
      const int n_w1 = (layer == 0) ? W1_UNITS : 0;
      const int total = n_up + n_pp + n_w1;
      for (int t = blockIdx.x; t < total; t += gridDim.x) {
        if (t < n_up) gemm_tile<EPI_UP, false>(g, t, lds);
        else if (t < n_up + n_pp) gemm_tile<EPI_PP, true>(q, t - n_up, lds);
        else phase_w1_unit(p, t - n_up - n_pp, lds);
      }
    } else {
      for (int t = blockIdx.x; t < n_up; t += gridDim.x) gemm_tile<EPI_UP, false>(g, t, lds);
    }
  } else if (sub == 1 || sub == 3) {
    const int mb = (sub == 1) ? 0 : 8192;
    GA g = ga_zero(); g.A = (const bf16_t*)(ws + ACT) - (size_t)mb * 4096; g.lda = 4096; g.Bt = wdn; g.K = 4096; g.N = 1024; g.MT = 64; g.m_base = mb;
    g.resid = p.out; g.xout = p.out; g.xb = xmid; g.rss_out = rss_mid;
    run_gemm<EPI_RES, false>(g, lds);
  } else {
    GA g = ga_zero(); g.A = xmid; g.lda = 1024; g.Bt = wgt; g.K = 1024; g.N = 1024; g.MT = 128;
    g.rss_in = (const float*)(ws + RSS_P); g.nparts = 16; g.pp = (const float*)(ws + PPB); g.c0 = p.in[26] + layer * 1024;
    g.resid = p.out; g.xout = p.out; g.xb = xnext; g.rss_out = rss_next;
    run_gemm<EPI_GATE, false>(g, lds);
  }
}

DI void run_phase(const Pm& pin, int ph, char* lds) {
  Pm p = pin;
  asm volatile("" : "+s"(p.ws), "+s"(p.out));
#pragma unroll
  for (int i = 0; i < 28; ++i) asm volatile("" : "+s"(p.in[i]));
  char* ws = p.ws;
  switch (ph) {
    case 0: phase0(p, lds); break;
    case 1: {
      GA g = ga_zero(); g.A = ws + XB_A; g.lda = 1024; g.Bt = (const bf16_t*)(ws + W_WIN); g.K = 1024; g.N = 3840; g.MT = 128;
      g.rss_in = (const float*)(ws + RSS_X0); g.nparts = 1; g.outb = (bf16_t*)(ws + U_OFF); g.c0 = (const float*)(ws + LBOFF); g.aux2 = (bf16_t*)(ws + BND);
      run_gemm<EPI_WIN, false>(g, lds);
    } break;
    case 2: {
      const int wv = tidx() >> 6;
      for (int t = blockIdx.x * 4 + wv; t < 1024; t += gridDim.x * 4) tokshift_unit(p, t);
    } break;
    case 3: {
      GA gw = ga_zero(); gw.A = (const bf16_t*)(ws + U_OFF) + 2048 + 1536; gw.lda = 3840; gw.Bt = (const bf16_t*)(ws + W_W2); gw.K = 64; gw.N = 512; gw.MT = 128;
      gw.c0 = p.in[9]; gw.outb = (bf16_t*)(ws + LOGD);
      GA gq = ga_zero(); gq.A = (const bf16_t*)(ws + U_OFF) + 2048 + 1600; gq.lda = 3840; gq.Bt = (const bf16_t*)(ws + W_A2); gq.K = 64; gq.N = 512; gq.MT = 128;
      gq.c0 = p.in[11]; gq.outb = (bf16_t*)(ws + AARR);
      for (int t = blockIdx.x; t < 1024; t += gridDim.x) { if (t < 512) gemm_tile<EPI_LW, false>(gw, t, lds); else gemm_tile<EPI_LA, false>(gq, t - 512, lds); }
    } break;
    case 4: {
      for (int u = blockIdx.x; u < 256; u += gridDim.x) { if (u < 128) rwkv_unit(p, u, lds); else hgrn_unit(p, u - 128, lds); }
    } break;
    case 5: {
      GA g = ga_zero(); g.A = (const bf16_t*)(ws + U_OFF) + 2048 + 1664; g.lda = 3840; g.Bt = (const bf16_t*)(ws + W_G2); g.K = 128; g.N = 512; g.MT = 128;
      g.auxb = (const bf16_t*)(ws + Y_OFF); g.auxf = (const float*)(ws + BONUS); g.c0 = p.in[17]; g.c1 = p.in[18]; g.outb = (bf16_t*)(ws + U_OFF);
      for (int t = blockIdx.x; t < 512 + 256; t += gridDim.x) { if (t < 512) gemm_tile<EPI_POSTB, false>(g, t, lds); else oapost_unit(p, t - 512); }
    } break;
    case 6: {
      GA g = ga_zero(); g.A = ws + U_OFF; g.lda = 3840; g.ksplit = 512; g.koff2 = 1536; g.Bt = (const bf16_t*)(ws + W_WOUT); g.K = 1024; g.N = 1024; g.MT = 128;
      g.resid = p.in[0]; g.xout = p.out; g.xb = (bf16_t*)(ws + XB_A); g.rss_out = (float*)(ws + RSS_A);
      run_gemm<EPI_RES, false>(g, lds);
    } break;
    case 7: case 8: case 9: case 10: case 11: mlp_phase(p, 0, ph - 7, lds); break;
    case 12: {
      GA g = ga_zero(); g.A = ws + XB_A; g.lda = 1024; g.Bt = (const bf16_t*)(ws + W_QKV); g.K = 1024; g.N = 3072; g.MT = 128;
      g.rss_in = (const float*)(ws + RSS_A); g.nparts = 16; g.outb = (bf16_t*)(ws + QKV);
      run_gemm<EPI_QKV, false>(g, lds);
    } break;
    case 13: for (int u = blockIdx.x; u < 512; u += gridDim.x) attnprep_unit(p, u, lds); break;
    case 14: for (int u = blockIdx.x; u < 1024; u += gridDim.x) attn_unit(p, u, lds); break;
    case 15: {
      GA g = ga_zero(); g.A = ws + QKV; g.lda = 3072; g.Bt = (const bf16_t*)(ws + W_WO); g.K = 1024; g.N = 1024; g.MT = 128;
      g.resid = p.out; g.xout = p.out; g.xb = (bf16_t*)(ws + XB_B); g.rss_out = (float*)(ws + RSS_B);
      run_gemm<EPI_RES, false>(g, lds);
    } break;
    case 16: case 17: case 18: case 19: case 20: mlp_phase(p, 1, ph - 16, lds); break;
    default: break;
  }
}

__global__ void __launch_bounds__(256) mega(Pm p, int ph_lo, int ph_hi) {
  extern __shared__ __attribute__((aligned(16))) char lds[];
  cg::grid_group grid = cg::this_grid();
  for (int ph = ph_lo; ph < ph_hi; ++ph) {
    run_phase(p, ph, lds);
    if (ph + 1 < ph_hi) grid.sync();
  }
}

extern "C" void kernel_launch(void* const* d_in, const int* in_sizes, int n_in, void* d_out, int out_size, void* d_ws, size_t ws_size, hipStream_t stream) {
  static int grid_blocks = 0;
  if (grid_blocks == 0) {
    if (n_in != 28 || out_size != M * 1024 || ws_size < WS_NEED) { fprintf(stderr, "kernel_launch: unexpected problem (n_in %d out %d ws %zu)\n", n_in, out_size, ws_size); grid_blocks = -1; return; }
    int dev = 0, cus = 0, per_cu = 0;
    hipGetDevice(&dev);
    hipDeviceGetAttribute(&cus, hipDeviceAttributeMultiprocessorCount, dev);
    if (hipFuncSetAttribute((const void*)mega, hipFuncAttributeMaxDynamicSharedMemorySize, LDS_BYTES) != hipSuccess) { fprintf(stderr, "hipFuncSetAttribute failed\n"); grid_blocks = -1; return; }
    hipOccupancyMaxActiveBlocksPerMultiprocessor(&per_cu, (const void*)mega, 256, LDS_BYTES);
    if (per_cu < 1) { fprintf(stderr, "occupancy query gave %d\n", per_cu); grid_blocks = -1; return; }
    if (per_cu > 2) per_cu = 2;
    grid_blocks = cus * per_cu;
    fprintf(stderr, "kernel_launch: %d CUs x %d blocks\n", cus, per_cu);
  }
  if (grid_blocks < 0) return;
  Pm p{};
  for (int i = 0; i < 28; ++i) p.in[i] = (const float*)d_in[i];
  p.out = (float*)d_out; p.ws = (char*)d_ws;
#if ONE_LAUNCH
  int lo = 0, hi = NPHASE;
  void* args[] = {&p, &lo, &hi};
  hipError_t e = hipLaunchCooperativeKernel((const void*)mega, dim3(grid_blocks), dim3(256), args, LDS_BYTES, stream);
  if (e != hipSuccess) fprintf(stderr, "cooperative launch failed: %s (grid %d)\n", hipGetErrorString(e), grid_blocks);
#else
  for (int ph = 0; ph < NPHASE; ++ph) hipLaunchKernelGGL(mega, dim3(grid_blocks), dim3(256), LDS_BYTES, stream, p, ph, ph + 1);
#endif
}
```

```cpp
#include <hip/hip_runtime.h>
#include <hip/hip_cooperative_groups.h>
#include <cstdio>
#include <cstdint>
namespace cg = cooperative_groups;

#ifndef ONE_LAUNCH
#define ONE_LAUNCH 1
#endif

typedef unsigned short bf16_t;
typedef short bf16x8 __attribute__((ext_vector_type(8)));
typedef short bf16x4 __attribute__((ext_vector_type(4)));
typedef float f32x16 __attribute__((ext_vector_type(16)));
typedef float f32x4 __attribute__((ext_vector_type(4)));
typedef unsigned u32x4 __attribute__((ext_vector_type(4)));
typedef unsigned u32x2 __attribute__((ext_vector_type(2)));
#define DI __device__ __forceinline__
#define LAS __attribute__((address_space(3)))
#define WAIT_V(n) asm volatile("s_waitcnt vmcnt(%0)" ::"n"(n) : "memory")
#define WAIT_L0() asm volatile("s_waitcnt lgkmcnt(0)" ::: "memory")
#define RAW_BARRIER() do { WAIT_L0(); __builtin_amdgcn_s_barrier(); asm volatile("" ::: "memory"); } while (0)
#define MFMA32(a, b, c) __builtin_amdgcn_mfma_f32_32x32x16_bf16((a), (b), (c), 0, 0, 0)

constexpr int M = 16384;
constexpr size_t MiB = 1u << 20;
constexpr size_t W_WIN = 0, W_WOUT = 7864320, W_UP0 = 9961472, W_DN0 = 18350080, W_PPJ0 = 26738688, W_PGT0 = 27262976,
                 W_W2 = 29360128, W_A2 = 29425664, W_G2 = 29491200;
constexpr size_t XB_A = 29 * MiB, XB_B = 61 * MiB;
constexpr size_t RSS_A = 93 * MiB, RSS_B = 94 * MiB, RSS_P = 95 * MiB;
constexpr size_t KMEAN = 96 * MiB, BONUS = 96 * MiB + 262144, LBOFF = 96 * MiB + 786432, RSS_X0 = 96 * MiB + 790528;
constexpr size_t R0 = 97 * MiB;
constexpr size_t U_OFF = R0, LOGD = R0 + 120 * MiB, AARR = R0 + 136 * MiB, BND = R0 + 152 * MiB;
constexpr size_t Y_OFF = XB_B, OA_OFF = XB_B + 16 * MiB;
constexpr size_t ACT = R0, PPB = R0 + 64 * MiB;
constexpr size_t W1 = R0 + 128 * MiB;
constexpr size_t W_QKV = W1, W_WO = W1 + 6291456, W_UP1 = W_WO + 2097152, W_DN1 = W_UP1 + 8388608, W_PPJ1 = W_DN1 + 8388608, W_PGT1 = W_PPJ1 + 524288;
constexpr size_t ROPE = R0 + 155 * MiB;
constexpr size_t QKV = R0, VT = R0 + 96 * MiB;
constexpr size_t WS_NEED = 256 * MiB;
constexpr int LSTR = 144;
constexpr int GSTAGE = 256 * LSTR;
constexpr int AUXOFF = 2 * GSTAGE;
constexpr int LDS_BYTES = AUXOFF + 1024;
constexpr float QSCALE = 0.08838834764831845f * 1.4426950408889634f;

struct Pm { const float* in[28]; float* out; char* ws; };

DI int tidx() { int t = __builtin_amdgcn_workitem_id_x(); asm volatile("" : "+v"(t)); return t; }
DI float bf2f(bf16_t v) { return __uint_as_float(((unsigned)v) << 16); }
DI bf16_t f2bf(float x) { unsigned u = __float_as_uint(x); u += 0x7fffu + ((u >> 16) & 1u); return (bf16_t)(u >> 16); }
DI unsigned pack2(float lo, float hi) { return (unsigned)f2bf(lo) | ((unsigned)f2bf(hi) << 16); }
DI float lo16(unsigned u) { return __uint_as_float(u << 16); }
DI float hi16(unsigned u) { return __uint_as_float(u & 0xffff0000u); }
DI float sigmoidf_(float x) { return 1.f / (1.f + __expf(-x)); }
template <int CTRL> DI float dppf(float x) { return __int_as_float(__builtin_amdgcn_update_dpp(0, __float_as_int(x), CTRL, 0xF, 0xF, true)); }
DI float allreduce16(float x) { x += dppf<0xB1>(x); x += dppf<0x4E>(x); x += dppf<0x141>(x); x += dppf<0x140>(x); return x; }
DI float allreduce32(float x) { x = allreduce16(x); x += __shfl_xor(x, 16); return x; }
DI float allreduce64(float x) { x = allreduce32(x); x += __shfl_xor(x, 32); return x; }

enum { EPI_WIN = 0, EPI_LW, EPI_LA, EPI_POSTB, EPI_RES, EPI_UP, EPI_PP, EPI_GATE, EPI_QKV };
struct GA {
  const void* A; int lda; int ksplit; int koff2;
  const bf16_t* Bt; int K; int N; int MT; int m_base;
  const float* rss_in; int nparts; float* rss_out;
  const float* resid; float* xout; bf16_t* xb;
  bf16_t* outb;
  const float* c0; const float* c1; const float* c2;
  const float* pp; const bf16_t* auxb; bf16_t* aux2; const float* auxf;
};

template <int EPI, bool AF32>
DI void gemm_tile(const GA& g, int t, char* lds) {
  const int tid = tidx(), wv = tid >> 6, l = tid & 63, hl = l >> 5, lq = l & 31, wm = wv >> 1, wn = wv & 1;
  constexpr int MF = AF32 ? 2 : 4;
  constexpr int TM = MF * 64;
  const int NT = g.N >> 7;
  const int x = t & 7, j = t >> 3, MTx = (AF32 ? g.MT : (g.MT >> 1)) >> 3;
  const int G = MTx < 8 ? MTx : 8;
  const int mi = j % G, j1 = j / G, nt = j1 % NT, mg = j1 / NT;
  const int mt = x * MTx + mg * G + mi;
  const int m0 = g.m_base + mt * TM, n0 = nt * 128;
  const int K = g.K, nk = K >> 6;
  f32x16 acc[MF][2];
#pragma unroll
  for (int a = 0; a < MF; ++a)
#pragma unroll
    for (int b = 0; b < 2; ++b)
#pragma unroll
      for (int i = 0; i < 16; ++i) acc[a][b][i] = 0.f;
  if constexpr (AF32) {
  u32x4 ra0[4], rb0[4], ra1[4], rb1[4];
  const int lrow = tid >> 3, lkc = tid & 7;
  const char* Ag = (const char*)g.A + ((size_t)(m0 + lrow) * g.lda) * (AF32 ? 4 : 2) + lkc * (AF32 ? 32 : 16);
  const char* Bg = (const char*)(g.Bt + (size_t)(n0 + lrow) * K + lkc * 8);
  const size_t astep = (size_t)32 * g.lda * (AF32 ? 4 : 2), bstep = (size_t)32 * K * 2;
#define GLOAD(kt, RA, RB) { const int k0_ = (kt) << 6; const int acol_ = (k0_ < g.ksplit) ? k0_ : k0_ + g.koff2; \
    _Pragma("unroll") for (int i = 0; i < 4; ++i) { \
      if (AF32) { const float* ap_ = (const float*)(Ag + i * astep) + acol_; const f32x4 v0_ = *(const f32x4*)ap_, v1_ = *(const f32x4*)(ap_ + 4); \
        RA[i][0] = pack2(v0_[0], v0_[1]); RA[i][1] = pack2(v0_[2], v0_[3]); RA[i][2] = pack2(v1_[0], v1_[1]); RA[i][3] = pack2(v1_[2], v1_[3]); } \
      else RA[i] = *(const u32x4*)(Ag + i * astep + (size_t)acol_ * 2); \
      RB[i] = *(const u32x4*)(Bg + i * bstep + (size_t)k0_ * 2); } }
  const int lsoff = lrow * LSTR + lkc * 16;
#define LSTORE(buf, RA, RB) { char* base_ = lds + (buf) * GSTAGE + lsoff; \
    _Pragma("unroll") for (int i = 0; i < 4; ++i) { *(u32x4*)(base_ + i * 32 * LSTR) = RA[i]; *(u32x4*)(base_ + 128 * LSTR + i * 32 * LSTR) = RB[i]; } }
  const int aoff = (wm * 64 + lq) * LSTR + hl * 16, boff = (128 + wn * 64 + lq) * LSTR + hl * 16;
#define COMPUTE(buf) { const char* Ab_ = lds + (buf) * GSTAGE + aoff; const char* Bb_ = lds + (buf) * GSTAGE + boff; \
    _Pragma("unroll") for (int ks = 0; ks < 4; ++ks) { bf16x8 af_[2], bf_[2]; \
      _Pragma("unroll") for (int f = 0; f < 2; ++f) { af_[f] = *(const bf16x8*)(Ab_ + f * 32 * LSTR + ks * 32); bf_[f] = *(const bf16x8*)(Bb_ + f * 32 * LSTR + ks * 32); } \
      _Pragma("unroll") for (int a = 0; a < 2; ++a) _Pragma("unroll") for (int b = 0; b < 2; ++b) acc[a][b] = MFMA32(af_[a], bf_[b], acc[a][b]); } }
  GLOAD(0, ra0, rb0);
  if (nk > 1) GLOAD(1, ra1, rb1);
  LSTORE(0, ra0, rb0);
  __syncthreads();
  for (int kt = 0; kt < nk; kt += 2) {
    if (kt + 2 < nk) GLOAD(kt + 2, ra0, rb0);
    __builtin_amdgcn_sched_barrier(0);
    COMPUTE(0);
    __builtin_amdgcn_sched_barrier(0);
    if (kt + 1 < nk) LSTORE(1, ra1, rb1);
    __syncthreads();
    if (kt + 1 >= nk) break;
    if (kt + 3 < nk) GLOAD(kt + 3, ra1, rb1);
    __builtin_amdgcn_sched_barrier(0);
    COMPUTE(1);
    __builtin_amdgcn_sched_barrier(0);
    if (kt + 2 < nk) LSTORE(0, ra0, rb0);
    __syncthreads();
  }
#undef GLOAD
#undef LSTORE
#undef COMPUTE
  } else {
    const int nk32 = K >> 5;
    const int srow = l >> 2, sc = ((l & 3) ^ ((l >> 4) & 3)) * 8;
    const bf16_t* Ap0 = (const bf16_t*)g.A + (size_t)(m0 + 16 * wv + srow) * g.lda + sc;
    const size_t a64 = (size_t)64 * g.lda;
    const bf16_t* Bp0 = g.Bt + (size_t)(n0 + 16 * wv + srow) * K + sc;
    const bf16_t* Bp1 = Bp0 + (size_t)64 * K;
    char* ldst = lds + wv * 1024 + l * 16;
#define GSTAGE_ISSUE(tt) { const int k0_ = (tt) << 5; const int acol_ = (k0_ < g.ksplit) ? k0_ : k0_ + g.koff2; char* d_ = ldst + ((tt) % 3) * 24576; \
      __builtin_amdgcn_global_load_lds((const unsigned*)(Ap0 + acol_), (LAS unsigned*)(d_), 16, 0, 0); \
      __builtin_amdgcn_global_load_lds((const unsigned*)(Ap0 + a64 + acol_), (LAS unsigned*)(d_ + 4096), 16, 0, 0); \
      __builtin_amdgcn_global_load_lds((const unsigned*)(Ap0 + 2 * a64 + acol_), (LAS unsigned*)(d_ + 8192), 16, 0, 0); \
      __builtin_amdgcn_global_load_lds((const unsigned*)(Ap0 + 3 * a64 + acol_), (LAS unsigned*)(d_ + 12288), 16, 0, 0); \
      __builtin_amdgcn_global_load_lds((const unsigned*)(Bp0 + k0_), (LAS unsigned*)(d_ + 16384), 16, 0, 0); \
      __builtin_amdgcn_global_load_lds((const unsigned*)(Bp1 + k0_), (LAS unsigned*)(d_ + 20480), 16, 0, 0); }
    const int fsw = (lq >> 2) & 3;
    const int a0off = (wm * 128 + lq) * 64 + ((hl ^ fsw) << 4), b0off = 16384 + (wn * 64 + lq) * 64 + ((hl ^ fsw) << 4);
    WAIT_V(0);
    __syncthreads();
    GSTAGE_ISSUE(0);
    if (nk32 > 1) GSTAGE_ISSUE(1);
    int st3 = 0;
    for (int t = 0; t < nk32; ++t) {
      if (t + 1 < nk32) WAIT_V(6); else WAIT_V(0);
      RAW_BARRIER();
      if (t + 2 < nk32) GSTAGE_ISSUE(t + 2);
      const char* sb_ = lds + st3 * 24576;
      st3 = (st3 == 2) ? 0 : st3 + 1;
#pragma unroll
      for (int ks = 0; ks < 2; ++ks) {
        const char* Ab_ = sb_ + (ks ? (a0off ^ 32) : a0off); const char* Bb_ = sb_ + (ks ? (b0off ^ 32) : b0off);
        bf16x8 af[4], bq[2];
#pragma unroll
        for (int f = 0; f < 4; ++f) af[f] = *(const bf16x8*)(Ab_ + f * 2048);
        bq[0] = *(const bf16x8*)(Bb_); bq[1] = *(const bf16x8*)(Bb_ + 2048);
#pragma unroll
        for (int a = 0; a < 4; ++a)
#pragma unroll
          for (int b = 0; b < 2; ++b) acc[a][b] = MFMA32(af[a], bq[b], acc[a][b]);
      }
    }
    WAIT_L0();
    __syncthreads();
#undef GSTAGE_ISSUE
  }
  float* rs = (float*)(lds + AUXOFF);
  if (EPI == EPI_WIN || EPI == EPI_UP || EPI == EPI_QKV || EPI == EPI_GATE) {
    if (tid < TM) {
      float s = 0.f;
      for (int q = 0; q < g.nparts; ++q) s += g.rss_in[(size_t)q * M + m0 + tid];
      rs[tid] = rsqrtf(s * (1.f / 1024.f) + 1e-6f);
    }
    __syncthreads();
  }
#pragma unroll
  for (int mf = 0; mf < MF; ++mf) {
#pragma unroll
    for (int i = 0; i < 16; ++i) {
      const int rl = wm * (MF * 32) + mf * 32 + (i & 3) + 8 * (i >> 2) + 4 * hl;
      const int row = m0 + rl;
      const int colb = n0 + wn * 64 + lq;
      float v0 = acc[mf][0][i], v1 = acc[mf][1][i];
      if (EPI == EPI_WIN) {
        const float r = rs[rl]; v0 *= r; v1 *= r;
        float o0, o1;
        if (n0 < 512 || (n0 >= 1536 && n0 < 2048)) { o0 = v0 * sigmoidf_(v0); o1 = v1 * sigmoidf_(v1); }
        else if (n0 < 1024) {
          const float lb0 = g.c0[colb - 512], lb1 = g.c0[colb + 32 - 512];
          o0 = logf(lb0 + (1.f - lb0) * sigmoidf_(v0)); o1 = logf(lb1 + (1.f - lb1) * sigmoidf_(v1));
        } else { o0 = v0; o1 = v1; }
        const bf16_t b0 = f2bf(o0), b1 = f2bf(o1);
        g.outb[(size_t)row * 3840 + colb] = b0; g.outb[(size_t)row * 3840 + colb + 32] = b1;
        if (n0 >= 2048 && (row & 15) == 15) { bf16_t* bd = g.aux2 + (size_t)(row >> 4) * 1792 + (colb - 2048); bd[0] = b0; bd[32] = b1; }
      } else if (EPI == EPI_LW) {
        float z0 = -(g.c0[colb] + v0), z1 = -(g.c0[colb + 32] + v1);
        const float sp0 = z0 > 20.f ? z0 : log1pf(expf(z0)), sp1 = z1 > 20.f ? z1 : log1pf(expf(z1));
        g.outb[(size_t)row * 512 + colb] = f2bf(-expf(-sp0 - 0.5f)); g.outb[(size_t)row * 512 + colb + 32] = f2bf(-expf(-sp1 - 0.5f));
      } else if (EPI == EPI_LA) {
        g.outb[(size_t)row * 512 + colb] = f2bf(sigmoidf_(g.c0[colb] + v0)); g.outb[(size_t)row * 512 + colb + 32] = f2bf(sigmoidf_(g.c0[colb + 32] + v1));
      } else if (EPI == EPI_POSTB) {
        const float y0 = bf2f(g.auxb[(size_t)row * 512 + colb]), y1 = bf2f(g.auxb[(size_t)row * 512 + colb + 32]);
        const float s1 = allreduce32(y0 + y1) * (1.f / 64.f);
        const float d0 = y0 - s1, d1 = y1 - s1;
        const float var = allreduce32(d0 * d0 + d1 * d1) * (1.f / 64.f);
        const float rstd = rsqrtf(var + 64e-5f);
        const int head = (n0 >> 6) + wn;
        const float bon = g.auxf[(size_t)row * 8 + head];
        bf16_t* ur = g.outb + (size_t)row * 3840 + 2048;
        const float vv0 = bf2f(ur[1024 + colb]), vv1 = bf2f(ur[1024 + colb + 32]);
        const float o0 = (d0 * rstd * g.c0[colb] + g.c1[colb] + bon * vv0) * v0;
        const float o1 = (d1 * rstd * g.c0[colb + 32] + g.c1[colb + 32] + bon * vv1) * v1;
        ur[colb] = f2bf(o0); ur[colb + 32] = f2bf(o1);
      } else if (EPI == EPI_RES || EPI == EPI_GATE) {
        const size_t o = (size_t)row * 1024 + colb;
        float x0, x1;
        if (EPI == EPI_RES) { x0 = g.resid[o] + v0; x1 = g.resid[o + 32] + v1; }
        else {
          const float r = rs[rl];
          x0 = g.resid[o] + g.pp[o] * r * g.c0[colb] * sigmoidf_(v0);
          x1 = g.resid[o + 32] + g.pp[o + 32] * r * g.c0[colb + 32] * sigmoidf_(v1);
        }
        g.xout[o] = x0; g.xout[o + 32] = x1;
        g.xb[o] = f2bf(x0); g.xb[o + 32] = f2bf(x1);
        const float ss = allreduce32(x0 * x0 + x1 * x1);
        if (lq == 0) g.rss_out[(size_t)(nt * 2 + wn) * M + row] = ss;
      } else if (EPI == EPI_UP) {
        const float r = rs[rl];
        float a0 = fmaxf(v0 * r, 0.f), a1 = fmaxf(v1 * r, 0.f);
        g.outb[(size_t)row * 4096 + colb] = f2bf(a0 * a0); g.outb[(size_t)row * 4096 + colb + 32] = f2bf(a1 * a1);
      } else if (EPI == EPI_PP) {
        const size_t o = (size_t)row * 1024 + colb;
        g.xout[o] = v0; g.xout[o + 32] = v1;
        const float ss = allreduce32(v0 * v0 + v1 * v1);
        if (lq == 0) g.rss_out[(size_t)(nt * 2 + wn) * M + row] = ss;
      } else if (EPI == EPI_QKV) {
        const float r = rs[rl];
        g.outb[(size_t)row * 3072 + colb] = f2bf(v0 * r); g.outb[(size_t)row * 3072 + colb + 32] = f2bf(v1 * r);
      }
    }
  }
}

struct TJob { const float* src; bf16_t* dst; const float* gain; int K, N; };
DI void transpose_unit(const TJob& j, int unit, char* ldsc) {
  float* lds = (float*)ldsc;
  const int tid = tidx();
  const int nkt = j.K >> 6, kt = unit % nkt, nt = unit / nkt;
#pragma unroll
  for (int i = 0; i < 4; ++i) {
    const int r = (tid >> 4) + 16 * i, c4 = (tid & 15) * 4, k = kt * 64 + r;
    const f32x4 v = *(const f32x4*)(j.src + (size_t)k * j.N + nt * 64 + c4);
    const float gn = j.gain ? j.gain[k] : 1.f;
    lds[r * 65 + c4] = v[0] * gn; lds[r * 65 + c4 + 1] = v[1] * gn; lds[r * 65 + c4 + 2] = v[2] * gn; lds[r * 65 + c4 + 3] = v[3] * gn;
  }
  __syncthreads();
#pragma unroll
  for (int i = 0; i < 2; ++i) {
    const int n = (tid >> 3) + 32 * i, k8 = (tid & 7) * 8;
    u32x4 o;
    o[0] = pack2(lds[(k8 + 0) * 65 + n], lds[(k8 + 1) * 65 + n]); o[1] = pack2(lds[(k8 + 2) * 65 + n], lds[(k8 + 3) * 65 + n]);
    o[2] = pack2(lds[(k8 + 4) * 65 + n], lds[(k8 + 5) * 65 + n]); o[3] = pack2(lds[(k8 + 6) * 65 + n], lds[(k8 + 7) * 65 + n]);
    *(u32x4*)(j.dst + (size_t)(nt * 64 + n) * j.K + kt * 64 + k8) = o;
  }
  __syncthreads();
}
#define TJ(SRC, DST, GAIN, KK, NN) { const int n_ = ((KK) >> 6) * ((NN) >> 6); if (uu < n_) { TJob j_; j_.src = (SRC); j_.dst = (bf16_t*)(DST); j_.gain = (GAIN); j_.K = (KK); j_.N = (NN); transpose_unit(j_, uu, lds); return; } uu -= n_; }
DI void tjobs0(const Pm& p, int uu, char* lds) {
  char* ws = p.ws;
  TJ(p.in[4], ws + W_WIN, p.in[2], 1024, 3840)
  TJ(p.in[5], ws + W_WOUT, nullptr, 1024, 1024)
  TJ(p.in[23], ws + W_UP0, p.in[3], 1024, 4096)
  TJ(p.in[24], ws + W_DN0, nullptr, 4096, 1024)
  TJ(p.in[25], ws + W_PPJ0, nullptr, 256, 1024)
  TJ(p.in[27], ws + W_PGT0, nullptr, 1024, 1024)
  TJ(p.in[10], ws + W_W2, nullptr, 64, 512)
  TJ(p.in[12], ws + W_A2, nullptr, 64, 512)
  TJ(p.in[13], ws + W_G2, nullptr, 128, 512)
}
DI void tjobs1(const Pm& p, int uu, char* lds) {
  char* ws = p.ws;
  TJ(p.in[19], ws + W_QKV, p.in[2] + 1024, 1024, 3072)
  TJ(p.in[20], ws + W_WO, nullptr, 1024, 1024)
  TJ(p.in[23] + (size_t)1024 * 4096, ws + W_UP1, p.in[3] + 1024, 1024, 4096)
  TJ(p.in[24] + (size_t)4096 * 1024, ws + W_DN1, nullptr, 4096, 1024)
  TJ(p.in[25] + (size_t)256 * 1024, ws + W_PPJ1, nullptr, 256, 1024)
  TJ(p.in[27] + (size_t)1024 * 1024, ws + W_PGT1, nullptr, 1024, 1024)
}
DI void phase0(const Pm& p, char* lds) {
  char* ws = p.ws;
  constexpr int NT_UNITS = 960 + 256 + 1024 + 1024 + 64 + 256 + 8 + 8 + 16;
  constexpr int NX_UNITS = 256;
  const int total = NT_UNITS + NX_UNITS + 1;
  const int tid = tidx(), wv = tid >> 6, l = tid & 63;
  for (int u = blockIdx.x; u < total; u += gridDim.x) {
    if (u < NT_UNITS) { tjobs0(p, u, lds); }
    else if (u < NT_UNITS + NX_UNITS) {
      const int r0 = (u - NT_UNITS) * 64 + wv * 16;
      const float* x = p.in[0]; bf16_t* xb = (bf16_t*)(ws + XB_A); float* rss = (float*)(ws + RSS_X0);
      for (int r = r0; r < r0 + 16; ++r) {
        float ss = 0.f;
#pragma unroll
        for (int q = 0; q < 4; ++q) {
          const f32x4 v = *(const f32x4*)(x + (size_t)r * 1024 + q * 256 + l * 4);
          ss += v[0] * v[0] + v[1] * v[1] + v[2] * v[2] + v[3] * v[3];
          u32x2 o; o[0] = pack2(v[0], v[1]); o[1] = pack2(v[2], v[3]);
          *(u32x2*)(xb + (size_t)r * 1024 + q * 256 + l * 4) = o;
        }
        ss = allreduce64(ss);
        if (l == 0) rss[r] = ss;
      }
    } else {
      const float* hl = p.in[6]; float* lb = (float*)(ws + LBOFF);
      for (int c = tid; c < 512; c += 256) {
        const float a0 = hl[c], a1 = hl[512 + c], a2 = hl[1024 + c];
        const float mx = fmaxf(a0, fmaxf(a1, a2));
        const float e0 = expf(a0 - mx), e1 = expf(a1 - mx), e2 = expf(a2 - mx);
        lb[c] = e0 / (e0 + e1 + e2);
      }
    }
  }
}

DI void phase_w1_unit(const Pm& p, int u, char* lds) {
  char* ws = p.ws;
  constexpr int NT_UNITS = 768 + 256 + 1024 + 1024 + 64 + 256;
  if (u < NT_UNITS) { tjobs1(p, u, lds); }
  else {
    const int idx0 = (u - NT_UNITS) * 256 + tidx();
    const int s = idx0 >> 6, i = idx0 & 63;
    const float inv_freq = powf(10000.f, -(float)i / 64.f);
    const float ang = (float)s * inv_freq;
    float2 cs; cs.x = (float)cos((double)ang); cs.y = (float)sin((double)ang);
    ((float2*)(ws + ROPE))[idx0] = cs;
  }
}
constexpr int W1_UNITS = 3392 + 1024;

DI void tokshift_unit(const Pm& p, int tile) {
  char* ws = p.ws;
  const int l = tidx() & 63;
  bf16_t* U = (bf16_t*)(ws + U_OFF);
  const bf16_t* bnd = (const bf16_t*)(ws + BND);
  const float* mu = p.in[8];
  const int t0 = tile * 16;
  u32x2 cur[7], prv[7];
#pragma unroll
  for (int j = 0; j < 7; ++j) cur[j] = *(const u32x2*)(U + (size_t)(t0 + 15) * 3840 + 2048 + j * 256 + l * 4);
  for (int r = 15; r >= 0; --r) {
    const bool zero = (r == 0) && ((t0 & 4095) == 0);
    const bf16_t* pr = (r > 0) ? (U + (size_t)(t0 + r - 1) * 3840 + 2048) : (bnd + (size_t)(tile - 1) * 1792);
#pragma unroll
    for (int j = 0; j < 7; ++j) { if (zero) { prv[j][0] = 0; prv[j][1] = 0; } else prv[j] = *(const u32x2*)(pr + j * 256 + l * 4); }
#pragma unroll
    for (int j = 0; j < 7; ++j) {
      const int c = j * 256 + l * 4;
      const f32x4 m = *(const f32x4*)(mu + c);
      float o[4];
      o[0] = lo16(cur[j][0]); o[1] = hi16(cur[j][0]); o[2] = lo16(cur[j][1]); o[3] = hi16(cur[j][1]);
      const float q0 = lo16(prv[j][0]), q1 = hi16(prv[j][0]), q2 = lo16(prv[j][1]), q3 = hi16(prv[j][1]);
      o[0] += (q0 - o[0]) * m[0]; o[1] += (q1 - o[1]) * m[1]; o[2] += (q2 - o[2]) * m[2]; o[3] += (q3 - o[3]) * m[3];
      if (j == 6) {
        if (l < 16) { for (int e = 0; e < 4; ++e) o[e] = tanhf(o[e]); }
        else if (l >= 32) { for (int e = 0; e < 4; ++e) o[e] = sigmoidf_(o[e]); }
      }
      u32x2 w; w[0] = pack2(o[0], o[1]); w[1] = pack2(o[2], o[3]);
      *(u32x2*)(U + (size_t)(t0 + r) * 3840 + 2048 + c) = w;
      cur[j] = prv[j];
    }
  }
}

DI void rwkv_unit(const Pm& p, int u, char* lds) {
  char* ws = p.ws;
  const int bh = u & 31, qtr = u >> 5, b = bh >> 3, h = bh & 7;
  const int tid = tidx(), wv = tid >> 6, l = tid & 63, rg = l >> 4, c = l & 15;
  const int row = qtr * 16 + wv * 4 + rg;
  const int tk = tid >> 4, cg = tid & 15, hc = h * 64 + cg * 4;
  const bf16_t* U = (const bf16_t*)(ws + U_OFF);
  const bf16_t* AA = (const bf16_t*)(ws + AARR);
  const bf16_t* LD = (const bf16_t*)(ws + LOGD);
  bf16_t* Y = (bf16_t*)(ws + Y_OFF);
  float* bonus = (float*)(ws + BONUS);
  const f32x4 kkc = *(const f32x4*)(p.in[14] + hc), kac = *(const f32x4*)(p.in[15] + hc), rkc = *(const f32x4*)(p.in[16] + hc);
  float S0 = 0.f, S1 = 0.f, S2 = 0.f, S3 = 0.f;
  u32x2 gr, gk, gv, ga, gl;
  auto gload = [&](int ch) {
    const size_t tok = (size_t)b * 4096 + ch * 16 + tk;
    const bf16_t* up = U + tok * 3840 + 2048 + hc;
    gr = *(const u32x2*)up; gk = *(const u32x2*)(up + 512); gv = *(const u32x2*)(up + 1024);
    ga = *(const u32x2*)(AA + tok * 512 + hc); gl = *(const u32x2*)(LD + tok * 512 + hc);
  };
  auto stage = [&](int ch, int buf) {
    char* base = lds + buf * 24576 + tk * 256 + cg * 16;
    f32x4 r, k, v, a, ld;
    r[0] = lo16(gr[0]); r[1] = hi16(gr[0]); r[2] = lo16(gr[1]); r[3] = hi16(gr[1]);
    k[0] = lo16(gk[0]); k[1] = hi16(gk[0]); k[2] = lo16(gk[1]); k[3] = hi16(gk[1]);
    v[0] = lo16(gv[0]); v[1] = hi16(gv[0]); v[2] = lo16(gv[1]); v[3] = hi16(gv[1]);
    a[0] = lo16(ga[0]); a[1] = hi16(ga[0]); a[2] = lo16(ga[1]); a[3] = hi16(ga[1]);
    ld[0] = lo16(gl[0]); ld[1] = hi16(gl[0]); ld[2] = lo16(gl[1]); ld[3] = hi16(gl[1]);
    f32x4 kx, kk, kf, kka, w;
    float ss = 0.f, bon = 0.f;
#pragma unroll
    for (int e = 0; e < 4; ++e) { kx[e] = k[e] * kkc[e]; ss += kx[e] * kx[e]; }
    ss = allreduce16(ss);
    const float inv = 1.f / fmaxf(sqrtf(ss), 1e-12f);
#pragma unroll
    for (int e = 0; e < 4; ++e) {
      kk[e] = kx[e] * inv; kf[e] = k[e] * (1.f + (a[e] - 1.f) * kac[e]); kka[e] = kk[e] * a[e]; w[e] = __expf(ld[e]);
      bon += r[e] * kf[e] * rkc[e];
    }
    bon = allreduce16(bon);
    if (qtr == 0 && cg == 0) bonus[((size_t)b * 4096 + ch * 16 + tk) * 8 + h] = bon;
    *(f32x4*)(base) = w; *(f32x4*)(base + 4096) = kk; *(f32x4*)(base + 8192) = kka; *(f32x4*)(base + 12288) = kf; *(f32x4*)(base + 16384) = r; *(f32x4*)(base + 20480) = v;
  };
  gload(0); stage(0, 0); __syncthreads();
  for (int ch = 0; ch < 256; ++ch) {
    if (ch + 1 < 256) gload(ch + 1);
    const char* base = lds + (ch & 1) * 24576;
    float ykeep = 0.f;
#pragma unroll 4
    for (int s = 0; s < 16; ++s) {
      const char* bs = base + s * 256 + c * 16;
      const f32x4 w = *(const f32x4*)(bs), kk = *(const f32x4*)(bs + 4096), kka = *(const f32x4*)(bs + 8192), k = *(const f32x4*)(bs + 12288), r = *(const f32x4*)(bs + 16384);
      const float v = *(const float*)(base + 20480 + s * 256 + row * 4);
      float d = S0 * kk[0] + S1 * kk[1] + S2 * kk[2] + S3 * kk[3];
      d = allreduce16(d);
      const float sa = -d;
      S0 = S0 * w[0] + sa * kka[0] + v * k[0]; S1 = S1 * w[1] + sa * kka[1] + v * k[1];
      S2 = S2 * w[2] + sa * kka[2] + v * k[2]; S3 = S3 * w[3] + sa * kka[3] + v * k[3];
      float y = S0 * r[0] + S1 * r[1] + S2 * r[2] + S3 * r[3];
      y = allreduce16(y);
      if (c == s) ykeep = y;
    }
    Y[((size_t)b * 4096 + ch * 16 + c) * 512 + h * 64 + row] = f2bf(ykeep);
    if (ch + 1 < 256) stage(ch + 1, (ch + 1) & 1);
    __syncthreads();
  }
}

DI void hgrn_unit(const Pm& p, int u, char* lds) {
  char* ws = p.ws;
  const int bh = u & 15, vs = u >> 4, b = bh >> 2, h = bh & 3;
  const int tid = tidx(), wv = tid >> 6, l = tid & 63, rg = l >> 4, c = l & 15;
  const int vcol = wv * 4 + rg;
  const int tk = tid >> 4, cg = tid & 15;
  const bf16_t* U = (const bf16_t*)(ws + U_OFF);
  bf16_t* OA = (bf16_t*)(ws + OA_OFF);
  float S[8];
#pragma unroll
  for (int e = 0; e < 8; ++e) S[e] = 0.f;
  u32x4 gq, gf; bf16_t gvv;
  auto gload = [&](int ch) {
    const size_t tok = (size_t)b * 4096 + ch * 16 + tk;
    const bf16_t* up = U + tok * 3840 + h * 128;
    gq = *(const u32x4*)(up + cg * 8); gf = *(const u32x4*)(up + 512 + cg * 8); gvv = up[1024 + vs * 16 + cg];
  };
  auto stage = [&](int buf) {
    char* base = lds + buf * 25600;
    f32x4 f0, f1, k0, k1, q0, q1;
#pragma unroll
    for (int e = 0; e < 2; ++e) {
      f0[2 * e] = __expf(lo16(gf[e])); f0[2 * e + 1] = __expf(hi16(gf[e])); f1[2 * e] = __expf(lo16(gf[2 + e])); f1[2 * e + 1] = __expf(hi16(gf[2 + e]));
      q0[2 * e] = lo16(gq[e]); q0[2 * e + 1] = hi16(gq[e]); q1[2 * e] = lo16(gq[2 + e]); q1[2 * e + 1] = hi16(gq[2 + e]);
    }
#pragma unroll
    for (int e = 0; e < 4; ++e) { k0[e] = 1.f - f0[e]; k1[e] = 1.f - f1[e]; }
    char* w = base + tk * 512 + cg * 32;
    *(f32x4*)(w) = f0; *(f32x4*)(w + 16) = f1; *(f32x4*)(w + 8192) = k0; *(f32x4*)(w + 8192 + 16) = k1; *(f32x4*)(w + 16384) = q0; *(f32x4*)(w + 16384 + 16) = q1;
    *(float*)(base + 24576 + tk * 64 + cg * 4) = bf2f(gvv);
  };
  gload(0); stage(0); __syncthreads();
  for (int ch = 0; ch < 256; ++ch) {
    if (ch + 1 < 256) gload(ch + 1);
    const char* base = lds + (ch & 1) * 25600;
    float ykeep = 0.f;
#pragma unroll 4
    for (int s = 0; s < 16; ++s) {
      const char* bs = base + s * 512 + c * 16;
      const f32x4 f0 = *(const f32x4*)(bs), f1 = *(const f32x4*)(bs + 256), k0 = *(const f32x4*)(bs + 8192), k1 = *(const f32x4*)(bs + 8192 + 256), q0 = *(const f32x4*)(bs + 16384), q1 = *(const f32x4*)(bs + 16384 + 256);
      const float v = *(const float*)(base + 24576 + s * 64 + vcol * 4);
      float a0 = 0.f, a1 = 0.f;
#pragma unroll
      for (int e = 0; e < 4; ++e) {
        S[e] = f0[e] * S[e] + k0[e] * v; a0 += S[e] * q0[e];
        S[4 + e] = f1[e] * S[4 + e] + k1[e] * v; a1 += S[4 + e] * q1[e];
      }
      const float y = allreduce16(a0 + a1);
      if (c == s) ykeep = y;
    }
    OA[((size_t)b * 4096 + ch * 16 + c) * 512 + h * 128 + vs * 16 + vcol] = f2bf(ykeep);
    if (ch + 1 < 256) stage((ch + 1) & 1);
    __syncthreads();
  }
}

DI void oapost_unit(const Pm& p, int unit) {
  char* ws = p.ws;
  const int wv = tidx() >> 6, l = tidx() & 63;
  const bf16_t* OA = (const bf16_t*)(ws + OA_OFF);
  bf16_t* U = (bf16_t*)(ws + U_OFF);
  const float* on = p.in[7] + l * 8;
  const f32x4 g0 = *(const f32x4*)on, g1 = *(const f32x4*)(on + 4);
  for (int r = 0; r < 16; ++r) {
    const size_t tok = (size_t)unit * 64 + wv * 16 + r;
    const u32x4 o = *(const u32x4*)(OA + tok * 512 + l * 8);
    const u32x4 hg = *(const u32x4*)(U + tok * 3840 + 1536 + l * 8);
    float v[8], gt[8];
#pragma unroll
    for (int e = 0; e < 4; ++e) { v[2 * e] = lo16(o[e]); v[2 * e + 1] = hi16(o[e]); gt[2 * e] = lo16(hg[e]); gt[2 * e + 1] = hi16(hg[e]); }
    float ss = 0.f;
#pragma unroll
    for (int e = 0; e < 8; ++e) ss += v[e] * v[e];
    ss = allreduce16(ss);
    const float inv = rsqrtf(ss * (1.f / 128.f) + 1e-6f);
    u32x4 w;
    w[0] = pack2(v[0] * inv * g0[0] * gt[0], v[1] * inv * g0[1] * gt[1]); w[1] = pack2(v[2] * inv * g0[2] * gt[2], v[3] * inv * g0[3] * gt[3]);
    w[2] = pack2(v[4] * inv * g1[0] * gt[4], v[5] * inv * g1[1] * gt[5]); w[3] = pack2(v[6] * inv * g1[2] * gt[6], v[7] * inv * g1[3] * gt[7]);
    *(u32x4*)(U + tok * 3840 + l * 8) = w;
  }
}

DI void attnprep_unit(const Pm& p, int unit, char* lds) {
  char* ws = p.ws;
  const int bh = unit & 31, blk = unit >> 5, b = bh >> 3, h = bh & 7;
  const int tid = tidx(), wv = tid >> 6, l = tid & 63;
  bf16_t* qkv = (bf16_t*)(ws + QKV);
  bf16_t* vt = (bf16_t*)(ws + VT);
  float* kmean = (float*)(ws + KMEAN);
  const float2* rope = (const float2*)(ws + ROPE);
  const float gq0 = p.in[21][l], gq1 = p.in[21][l + 64], gk0 = p.in[22][l], gk1 = p.in[22][l + 64];
  float ks0 = 0.f, ks1 = 0.f;
  for (int it = 0; it < 64; ++it) {
    const int s = blk * 256 + wv * 64 + it;
    const size_t rowo = ((size_t)b * 4096 + s) * 3072;
    const float2 cs = rope[s * 64 + l];
    {
      bf16_t* qp = qkv + rowo + h * 128;
      float x0 = bf2f(qp[l]), x1 = bf2f(qp[l + 64]);
      const float ss = allreduce64(x0 * x0 + x1 * x1);
      const float inv = rsqrtf(ss * (1.f / 128.f) + 1e-6f);
      x0 *= inv * gq0; x1 *= inv * gq1;
      const float o0 = x0 * cs.x - x1 * cs.y, o1 = x1 * cs.x + x0 * cs.y;
      qp[l] = f2bf(o0 * QSCALE); qp[l + 64] = f2bf(o1 * QSCALE);
    }
    {
      bf16_t* kp = qkv + rowo + 1024 + h * 128;
      float x0 = bf2f(kp[l]), x1 = bf2f(kp[l + 64]);
      const float ss = allreduce64(x0 * x0 + x1 * x1);
      const float inv = rsqrtf(ss * (1.f / 128.f) + 1e-6f);
      x0 *= inv * gk0; x1 *= inv * gk1;
      const float o0 = x0 * cs.x - x1 * cs.y, o1 = x1 * cs.x + x0 * cs.y;
      ks0 += o0; ks1 += o1;
      kp[l] = f2bf(o0); kp[l + 64] = f2bf(o1);
    }
  }
  float* red = (float*)lds;
  red[wv * 128 + l] = ks0; red[wv * 128 + 64 + l] = ks1;
  __syncthreads();
  if (tid < 128) kmean[((size_t)bh * 16 + blk) * 128 + tid] = (red[tid] + red[128 + tid] + red[256 + tid] + red[384 + tid]) * (1.f / 256.f);
  __syncthreads();
  for (int st = 0; st < 4; ++st) {
    const size_t tokbase = (size_t)b * 4096 + blk * 256 + st * 64;
#pragma unroll
    for (int i = 0; i < 4; ++i) {
      const int c = tid + 256 * i, r = c >> 4, ch = c & 15;
      *(u32x4*)(lds + r * 272 + ch * 16) = *(const u32x4*)(qkv + (tokbase + r) * 3072 + 2048 + h * 128 + ch * 8);
    }
    __syncthreads();
#pragma unroll
    for (int i = 0; i < 4; ++i) {
      const int d = tid & 127, t8 = (tid >> 7) + 2 * i;
      unsigned short e[8];
#pragma unroll
      for (int j = 0; j < 8; ++j) e[j] = *(const unsigned short*)(lds + (t8 * 8 + j) * 272 + d * 2);
      u32x4 o;
      o[0] = e[0] | ((unsigned)e[1] << 16); o[1] = e[2] | ((unsigned)e[3] << 16); o[2] = e[4] | ((unsigned)e[5] << 16); o[3] = e[6] | ((unsigned)e[7] << 16);
      *(u32x4*)(vt + ((size_t)bh * 128 + d) * 4096 + blk * 256 + st * 64 + t8 * 8) = o;
    }
    __syncthreads();
  }
}

constexpr int KSTR = 272, VSTR = 136, ASTAGE = 64 * KSTR + 128 * VSTR;
DI void attn_unit(const Pm& p, int unit, char* lds) {
  char* ws = p.ws;
  const int qt = 31 - (unit >> 5), bh = unit & 31, b = bh >> 3, h = bh & 7;
  const int tid = tidx(), wv = tid >> 6, l = tid & 63, hl = l >> 5, lq = l & 31;
  const int qb = qt >> 1;
  const size_t tok0 = (size_t)b * 4096 + qt * 128;
  const int myq = qt * 128 + wv * 32 + lq;
  bf16_t* qkv = (bf16_t*)(ws + QKV);
  const bf16_t* vt = (const bf16_t*)(ws + VT);
  const float* kmean = (const float*)(ws + KMEAN);
  const float NEG = -__builtin_inff();
  bf16x8 qf[8];
  {
    const bf16_t* qp = qkv + (tok0 + wv * 32 + lq) * 3072 + h * 128 + hl * 8;
#pragma unroll
    for (int ks = 0; ks < 8; ++ks) qf[ks] = *(const bf16x8*)(qp + ks * 16);
  }
  unsigned selmask = 0;
  unsigned* bm = (unsigned*)(lds + AUXOFF + 512);
  if (tid == 0) *bm = 0;
  if (qb > 0) {
    float* km = (float*)lds;
    for (int i = tid; i < qb * 128; i += 256) km[i] = kmean[(size_t)bh * 16 * 128 + i];
    __syncthreads();
    if (qb <= 3) selmask = (1u << qb) - 1u;
    else {
      float b0 = NEG, b1 = NEG, b2 = NEG; int i0 = 0, i1 = 0, i2 = 0;
      for (int n = 0; n < qb; ++n) {
        float gsum = 0.f;
#pragma unroll
        for (int ks = 0; ks < 8; ++ks) {
          const float* kr = km + n * 128 + ks * 16 + hl * 8;
#pragma unroll
          for (int j = 0; j < 8; ++j) gsum += bf2f((bf16_t)qf[ks][j]) * kr[j];
        }
        gsum += __shfl_xor(gsum, 32);
        if (gsum > b0) { b2 = b1; i2 = i1; b1 = b0; i1 = i0; b0 = gsum; i0 = n; }
        else if (gsum > b1) { b2 = b1; i2 = i1; b1 = gsum; i1 = n; }
        else if (gsum > b2) { b2 = gsum; i2 = n; }
      }
      selmask = (1u << i0) | (1u << i1) | (1u << i2);
    }
  }
  __syncthreads();
  if (selmask) atomicOr(bm, selmask);
  __syncthreads();
  const unsigned blkmask = *bm;
  const int own_tiles = (qt & 1) ? 4 : 2;
  int n = 0, kt = 0;
  while (n < qb && !((blkmask >> n) & 1u)) ++n;
  u32x4 rk[4], rv[4];
  auto gload = [&](int nn, int kk) {
    const int key0 = nn * 256 + kk * 64;
#pragma unroll
    for (int i = 0; i < 4; ++i) {
      const int c = tid + 256 * i;
      rk[i] = *(const u32x4*)(qkv + ((size_t)b * 4096 + key0 + (c >> 4)) * 3072 + 1024 + h * 128 + (c & 15) * 8);
      rv[i] = *(const u32x4*)(vt + ((size_t)bh * 128 + (c >> 3)) * 4096 + key0 + (c & 7) * 8);
    }
  };
  auto lstore = [&](int buf) {
    char* base = lds + buf * ASTAGE;
#pragma unroll
    for (int i = 0; i < 4; ++i) {
      const int c = tid + 256 * i;
      *(u32x4*)(base + (c >> 4) * KSTR + (c & 15) * 16) = rk[i];
      char* vp = base + 64 * KSTR + (c >> 3) * VSTR + (c & 7) * 16;
      u32x2 v0, v1; v0[0] = rv[i][0]; v0[1] = rv[i][1]; v1[0] = rv[i][2]; v1[1] = rv[i][3];
      *(u32x2*)vp = v0; *(u32x2*)(vp + 8) = v1;
    }
  };
  f32x16 oacc[4];
#pragma unroll
  for (int a = 0; a < 4; ++a)
#pragma unroll
    for (int i = 0; i < 16; ++i) oacc[a][i] = 0.f;
  float m_run = NEG, l_run = 0.f;
  gload(n, kt); lstore(0); __syncthreads();
  int st = 0;
  while (n <= qb) {
    int n2 = n, kt2 = kt + 1;
    if (kt2 >= ((n == qb) ? own_tiles : 4)) { kt2 = 0; ++n2; while (n2 < qb && !((blkmask >> n2) & 1u)) ++n2; }
    const bool has_next = (n2 <= qb);
    if (has_next) gload(n2, kt2);
    const char* Kb = lds + st * ASTAGE + lq * KSTR + hl * 16; const char* Vb = lds + st * ASTAGE + 64 * KSTR + lq * VSTR + hl * 8;
    const bool own = (n == qb);
    const bool allowed = own || ((selmask >> n) & 1u);
    const int key0 = n * 256 + kt * 64;
#pragma unroll
    for (int mf = 0; mf < 2; ++mf) {
      f32x16 sacc;
#pragma unroll
      for (int i = 0; i < 16; ++i) sacc[i] = 0.f;
#pragma unroll
      for (int ks = 0; ks < 8; ++ks) {
        const bf16x8 a = *(const bf16x8*)(Kb + mf * 32 * KSTR + ks * 32);
        sacc = MFMA32(a, qf[ks], sacc);
      }
      if (own) {
#pragma unroll
        for (int i = 0; i < 16; ++i) { const int kp = key0 + mf * 32 + (i & 3) + 8 * (i >> 2) + 4 * hl; if (kp > myq) sacc[i] = NEG; }
      } else if (!allowed) {
#pragma unroll
        for (int i = 0; i < 16; ++i) sacc[i] = NEG;
      }
      float mt = NEG;
#pragma unroll
      for (int i = 0; i < 16; ++i) mt = fmaxf(mt, sacc[i]);
      mt = fmaxf(mt, __shfl_xor(mt, 32));
      const float mnew = fmaxf(m_run, mt);
      const float muse = (mnew == NEG) ? 0.f : mnew;
      const float alpha = __builtin_amdgcn_exp2f(m_run - muse);
      m_run = mnew;
      float psum = 0.f;
#pragma unroll
      for (int i = 0; i < 16; ++i) { const float pe = __builtin_amdgcn_exp2f(sacc[i] - muse); sacc[i] = pe; psum += pe; }
      l_run = l_run * alpha + psum;
      if (__any(alpha != 1.f)) {
#pragma unroll
        for (int a = 0; a < 4; ++a)
#pragma unroll
          for (int i = 0; i < 16; ++i) oacc[a][i] *= alpha;
      }
      bf16x8 pf[2];
#pragma unroll
      for (int s2 = 0; s2 < 2; ++s2) {
        u32x4 pk;
#pragma unroll
        for (int e = 0; e < 4; ++e) pk[e] = pack2(sacc[8 * s2 + 2 * e], sacc[8 * s2 + 2 * e + 1]);
        pf[s2] = __builtin_bit_cast(bf16x8, pk);
      }
#pragma unroll
      for (int md = 0; md < 4; ++md) {
#pragma unroll
        for (int s2 = 0; s2 < 2; ++s2) {
          const int chunk = 4 * mf + 2 * s2;
          const bf16x4 lo = *(const bf16x4*)(Vb + md * 32 * VSTR + chunk * 16);
          const bf16x4 hi = *(const bf16x4*)(Vb + md * 32 * VSTR + chunk * 16 + 16);
          const bf16x8 a = __builtin_shufflevector(lo, hi, 0, 1, 2, 3, 4, 5, 6, 7);
          oacc[md] = MFMA32(a, pf[s2], oacc[md]);
        }
      }
    }
    if (has_next) lstore(st ^ 1);
    __syncthreads();
    n = n2; kt = kt2; st ^= 1;
  }
  const float ltot = l_run + __shfl_xor(l_run, 32);
  const float inv = 1.f / ltot;
  bf16_t* op = qkv + (tok0 + wv * 32 + lq) * 3072 + h * 128;
#pragma unroll
  for (int md = 0; md < 4; ++md)
#pragma unroll
    for (int i4 = 0; i4 < 4; ++i4) {
      u32x2 o; o[0] = pack2(oacc[md][4 * i4] * inv, oacc[md][4 * i4 + 1] * inv); o[1] = pack2(oacc[md][4 * i4 + 2] * inv, oacc[md][4 * i4 + 3] * inv);
      *(u32x2*)(op + md * 32 + 8 * i4 + 4 * hl) = o;
    }
  __syncthreads();
}

constexpr int NPHASE = 21;

DI GA ga_zero() { GA g; g.A = nullptr; g.lda = 0; g.ksplit = 1 << 30; g.koff2 = 0; g.Bt = nullptr; g.K = 0; g.N = 0; g.MT = 128; g.m_base = 0; g.rss_in = nullptr; g.nparts = 0; g.rss_out = nullptr;
  g.resid = nullptr; g.xout = nullptr; g.xb = nullptr; g.outb = nullptr; g.c0 = nullptr; g.c1 = nullptr; g.c2 = nullptr; g.pp = nullptr; g.auxb = nullptr; g.aux2 = nullptr; g.auxf = nullptr; return g; }

template <int EPI, bool AF32>
DI void run_gemm(const GA& g, char* lds) {
  const int total = (AF32 ? g.MT : (g.MT >> 1)) * (g.N >> 7);
  for (int t = blockIdx.x; t < total; t += gridDim.x) gemm_tile<EPI, AF32>(g, t, lds);
}

DI void mlp_phase(const Pm& p, int layer, int sub, char* lds) {
  char* ws = p.ws;
  const bf16_t* xin = (const bf16_t*)(ws + (layer == 0 ? XB_A : XB_B));
  bf16_t* xmid = (bf16_t*)(ws + (layer == 0 ? XB_B : XB_A));
  bf16_t* xnext = (bf16_t*)(ws + (layer == 0 ? XB_A : XB_B));
  const float* rss_in = (const float*)(ws + (layer == 0 ? RSS_A : RSS_B));
  float* rss_mid = (float*)(ws + (layer == 0 ? RSS_B : RSS_A));
  float* rss_next = (float*)(ws + (layer == 0 ? RSS_A : RSS_B));
  const bf16_t* wup = (const bf16_t*)(ws + (layer == 0 ? W_UP0 : W_UP1));
  const bf16_t* wdn = (const bf16_t*)(ws + (layer == 0 ? W_DN0 : W_DN1));
  const bf16_t* wpj = (const bf16_t*)(ws + (layer == 0 ? W_PPJ0 : W_PPJ1));
  const bf16_t* wgt = (const bf16_t*)(ws + (layer == 0 ? W_PGT0 : W_PGT1));
  if (sub == 0 || sub == 2) {
    const int mb = (sub == 0) ? 0 : 8192;
    GA g = ga_zero(); g.A = xin; g.lda = 1024; g.Bt = wup; g.K = 1024; g.N = 4096; g.MT = 64; g.m_base = mb;
    g.rss_in = rss_in; g.nparts = 16; g.outb = (bf16_t*)(ws + ACT) - (size_t)mb * 4096;
    const int n_up = 32 * 32;
    if (sub == 0) {
      GA q = ga_zero(); q.A = p.in[1] + (size_t)layer * M * 256; q.lda = 256; q.Bt = wpj; q.K = 256; q.N = 1024; q.MT = 128;
      q.xout = (float*)(ws + PPB); q.rss_out = (float*)(ws + RSS_P);
      const int n_pp = 128 * 8;
      const int n_w1 = (layer == 0) ? W1_UNITS : 0;
      const int total = n_up + n_pp + n_w1;
      for (int t = blockIdx.x; t < total; t += gridDim.x) {
        if (t < n_up) gemm_tile<EPI_UP, false>(g, t, lds);
        else if (t < n_up + n_pp) gemm_tile<EPI_PP, true>(q, t - n_up, lds);
        else phase_w1_unit(p, t - n_up - n_pp, lds);
      }
    } else {
      for (int t = blockIdx.x; t < n_up; t += gridDim.x) gemm_tile<EPI_UP, false>(g, t, lds);
    }
  } else if (sub == 1 || sub == 3) {
    const int mb = (sub == 1) ? 0 : 8192;
    GA g = ga_zero(); g.A = (const bf16_t*)(ws + ACT) - (size_t)mb * 4096; g.lda = 4096; g.Bt = wdn; g.K = 4096; g.N = 1024; g.MT = 64; g.m_base = mb;
    g.resid = p.out; g.xout = p.out; g.xb = xmid; g.rss_out = rss_mid;
    run_gemm<EPI_RES, false>(g, lds);
  } else {
    GA g = ga_zero(); g.A = xmid; g.lda = 1024; g.Bt = wgt; g.K = 1024; g.N = 1024; g.MT = 128;
    g.rss_in = (const float*)(ws + RSS_P); g.nparts = 16; g.pp = (const float*)(ws + PPB); g.c0 = p.in[26] + layer * 1024;
    g.resid = p.out; g.xout = p.out; g.xb = xnext; g.rss_out = rss_next;
    run_gemm<EPI_GATE, false>(g, lds);
  }
}

DI void run_phase(const Pm& pin, int ph, char* lds) {
  const Pm& p = pin;
  char* ws = p.ws;
  switch (ph) {
    case 0: phase0(p, lds); break;
    case 1: {
      GA g = ga_zero(); g.A = ws + XB_A; g.lda = 1024; g.Bt = (const bf16_t*)(ws + W_WIN); g.K = 1024; g.N = 3840; g.MT = 128;
      g.rss_in = (const float*)(ws + RSS_X0); g.nparts = 1; g.outb = (bf16_t*)(ws + U_OFF); g.c0 = (const float*)(ws + LBOFF); g.aux2 = (bf16_t*)(ws + BND);
      run_gemm<EPI_WIN, false>(g, lds);
    } break;
    case 2: {
      const int wv = tidx() >> 6;
      for (int t = blockIdx.x * 4 + wv; t < 1024; t += gridDim.x * 4) tokshift_unit(p, t);
    } break;
    case 3: {
      GA gw = ga_zero(); gw.A = (const bf16_t*)(ws + U_OFF) + 2048 + 1536; gw.lda = 3840; gw.Bt = (const bf16_t*)(ws + W_W2); gw.K = 64; gw.N = 512; gw.MT = 128;
      gw.c0 = p.in[9]; gw.outb = (bf16_t*)(ws + LOGD);
      GA gq = ga_zero(); gq.A = (const bf16_t*)(ws + U_OFF) + 2048 + 1600; gq.lda = 3840; gq.Bt = (const bf16_t*)(ws + W_A2); gq.K = 64; gq.N = 512; gq.MT = 128;
      gq.c0 = p.in[11]; gq.outb = (bf16_t*)(ws + AARR);
      for (int t = blockIdx.x; t < 512; t += gridDim.x) { if (t < 256) gemm_tile<EPI_LW, false>(gw, t, lds); else gemm_tile<EPI_LA, false>(gq, t - 256, lds); }
    } break;
    case 4: {
      for (int u = blockIdx.x; u < 256; u += gridDim.x) { if (u < 128) rwkv_unit(p, u, lds); else hgrn_unit(p, u - 128, lds); }
    } break;
    case 5: {
      GA g = ga_zero(); g.A = (const bf16_t*)(ws + U_OFF) + 2048 + 1664; g.lda = 3840; g.Bt = (const bf16_t*)(ws + W_G2); g.K = 128; g.N = 512; g.MT = 128;
      g.auxb = (const bf16_t*)(ws + Y_OFF); g.auxf = (const float*)(ws + BONUS); g.c0 = p.in[17]; g.c1 = p.in[18]; g.outb = (bf16_t*)(ws + U_OFF);
      for (int t = blockIdx.x; t < 256 + 256; t += gridDim.x) { if (t < 256) gemm_tile<EPI_POSTB, false>(g, t, lds); else oapost_unit(p, t - 256); }
    } break;
    case 6: {
      GA g = ga_zero(); g.A = ws + U_OFF; g.lda = 3840; g.ksplit = 512; g.koff2 = 1536; g.Bt = (const bf16_t*)(ws + W_WOUT); g.K = 1024; g.N = 1024; g.MT = 128;
      g.resid = p.in[0]; g.xout = p.out; g.xb = (bf16_t*)(ws + XB_A); g.rss_out = (float*)(ws + RSS_A);
      run_gemm<EPI_RES, false>(g, lds);
    } break;
    case 7: case 8: case 9: case 10: case 11: mlp_phase(p, 0, ph - 7, lds); break;
    case 12: {
      GA g = ga_zero(); g.A = ws + XB_A; g.lda = 1024; g.Bt = (const bf16_t*)(ws + W_QKV); g.K = 1024; g.N = 3072; g.MT = 128;
      g.rss_in = (const float*)(ws + RSS_A); g.nparts = 16; g.outb = (bf16_t*)(ws + QKV);
      run_gemm<EPI_QKV, false>(g, lds);
    } break;
    case 13: for (int u = blockIdx.x; u < 512; u += gridDim.x) attnprep_unit(p, u, lds); break;
    case 14: for (int u = blockIdx.x; u < 1024; u += gridDim.x) attn_unit(p, u, lds); break;
    case 15: {
      GA g = ga_zero(); g.A = ws + QKV; g.lda = 3072; g.Bt = (const bf16_t*)(ws + W_WO); g.K = 1024; g.N = 1024; g.MT = 128;
      g.resid = p.out; g.xout = p.out; g.xb = (bf16_t*)(ws + XB_B); g.rss_out = (float*)(ws + RSS_B);
      run_gemm<EPI_RES, false>(g, lds);
    } break;
    case 16: case 17: case 18: case 19: case 20: mlp_phase(p, 1, ph - 16, lds); break;
    default: break;
  }
}

__global__ void __launch_bounds__(256, 2) mega(Pm p, int ph_lo, int ph_hi) {
  extern __shared__ __attribute__((aligned(16))) char lds[];
  cg::grid_group grid = cg::this_grid();
#ifdef PROBE_LO
  long long pt0 = 0, pt1 = 0;
#endif
  for (int ph = ph_lo; ph < ph_hi; ++ph) {
#ifdef PROBE_LO
    if (ph == PROBE_LO) pt0 = wall_clock64();
#endif
    run_phase(p, ph, lds);
    if (ph + 1 < ph_hi) grid.sync();
#ifdef PROBE_LO
    if (ph == PROBE_HI - 1) pt1 = wall_clock64();
#endif
  }
#ifdef PROBE_LO
  if (blockIdx.x == 0 && tidx() == 0) { const long long te = wall_clock64(); while (wall_clock64() - te < (pt1 - pt0)) __builtin_amdgcn_s_sleep(8); }
#endif
}

extern "C" void kernel_launch(void* const* d_in, const int* in_sizes, int n_in, void* d_out, int out_size, void* d_ws, size_t ws_size, hipStream_t stream) {
  static int grid_blocks = 0;
  if (grid_blocks == 0) {
    if (n_in != 28 || out_size != M * 1024 || ws_size < WS_NEED) { fprintf(stderr, "kernel_launch: unexpected problem (n_in %d out %d ws %zu)\n", n_in, out_size, ws_size); grid_blocks = -1; return; }
    int dev = 0, cus = 0, per_cu = 0;
    hipGetDevice(&dev);
    hipDeviceGetAttribute(&cus, hipDeviceAttributeMultiprocessorCount, dev);
    if (hipFuncSetAttribute((const void*)mega, hipFuncAttributeMaxDynamicSharedMemorySize, LDS_BYTES) != hipSuccess) { fprintf(stderr, "hipFuncSetAttribute failed\n"); grid_blocks = -1; return; }
    hipOccupancyMaxActiveBlocksPerMultiprocessor(&per_cu, (const void*)mega, 256, LDS_BYTES);
    if (per_cu < 1) { fprintf(stderr, "occupancy query gave %d\n", per_cu); grid_blocks = -1; return; }
    if (per_cu > 2) per_cu = 2;
    grid_blocks = cus * per_cu;
    fprintf(stderr, "kernel_launch: %d CUs x %d blocks\n", cus, per_cu);
  }
  if (grid_blocks < 0) return;
  Pm p{};
  for (int i = 0; i < 28; ++i) p.in[i] = (const float*)d_in[i];
  p.out = (float*)d_out; p.ws = (char*)d_ws;
#if ONE_LAUNCH
  int lo = 0, hi = NPHASE;
  void* args[] = {&p, &lo, &hi};
  hipError_t e = hipLaunchCooperativeKernel((const void*)mega, dim3(grid_blocks), dim3(256), args, LDS_BYTES, stream);
  if (e != hipSuccess) fprintf(stderr, "cooperative launch failed: %s (grid %d)\n", hipGetErrorString(e), grid_blocks);
#else
  for (int ph = 0; ph < NPHASE; ++ph) hipLaunchKernelGGL(mega, dim3(grid_blocks), dim3(256), LDS_BYTES, stream, p, ph, ph + 1);
#endif
}
```

```cpp
#include <hip/hip_runtime.h>
#include <hip/hip_cooperative_groups.h>
#include <cstdio>
#include <cstdint>
namespace cg = cooperative_groups;

#ifndef ONE_LAUNCH
#define ONE_LAUNCH 1
#endif

typedef unsigned short bf16_t;
typedef short bf16x8 __attribute__((ext_vector_type(8)));
typedef short bf16x4 __attribute__((ext_vector_type(4)));
typedef float f32x16 __attribute__((ext_vector_type(16)));
typedef float f32x4 __attribute__((ext_vector_type(4)));
typedef unsigned u32x4 __attribute__((ext_vector_type(4)));
typedef unsigned u32x2 __attribute__((ext_vector_type(2)));
#define DI __device__ __forceinline__
#define LAS __attribute__((address_space(3)))
#define WAIT_V(n) asm volatile("s_waitcnt vmcnt(%0)" ::"n"(n) : "memory")
#define WAIT_L0() asm volatile("s_waitcnt lgkmcnt(0)" ::: "memory")
#define RAW_BARRIER() do { WAIT_L0(); __builtin_amdgcn_s_barrier(); asm volatile("" ::: "memory"); } while (0)
#define MFMA32(a, b, c) __builtin_amdgcn_mfma_f32_32x32x16_bf16((a), (b), (c), 0, 0, 0)

constexpr int M = 16384;
constexpr size_t MiB = 1u << 20;
constexpr size_t W_WIN = 0, W_WOUT = 7864320, W_UP0 = 9961472, W_DN0 = 18350080, W_PPJ0 = 26738688, W_PGT0 = 27262976,
                 W_W2 = 29360128, W_A2 = 29425664, W_G2 = 29491200;
constexpr size_t XB_A = 29 * MiB, XB_B = 61 * MiB;
constexpr size_t RSS_A = 93 * MiB, RSS_B = 94 * MiB, RSS_P = 95 * MiB;
constexpr size_t KMEAN = 96 * MiB, BONUS = 96 * MiB + 262144, LBOFF = 96 * MiB + 786432, RSS_X0 = 96 * MiB + 790528;
constexpr size_t R0 = 97 * MiB;
constexpr size_t U_OFF = R0, LOGD = R0 + 120 * MiB, AARR = R0 + 136 * MiB, BND = R0 + 152 * MiB;
constexpr size_t Y_OFF = XB_B, OA_OFF = XB_B + 16 * MiB;
constexpr size_t ACT = R0, PPB = R0 + 64 * MiB;
constexpr size_t W1 = R0 + 128 * MiB;
constexpr size_t W_QKV = W1, W_WO = W1 + 6291456, W_UP1 = W_WO + 2097152, W_DN1 = W_UP1 + 8388608, W_PPJ1 = W_DN1 + 8388608, W_PGT1 = W_PPJ1 + 524288;
constexpr size_t ROPE = R0 + 155 * MiB;
constexpr size_t QKV = R0, VT = R0 + 96 * MiB;
constexpr size_t WS_NEED = 256 * MiB;
constexpr int LSTR = 144;
constexpr int GSTAGE = 256 * LSTR;
constexpr int AUXOFF = 2 * GSTAGE;
constexpr int LDS_BYTES = AUXOFF + 1024;
constexpr float QSCALE = 0.08838834764831845f * 1.4426950408889634f;

struct Pm { const float* in[28]; float* out; char* ws; };

DI int tidx() { int t = __builtin_amdgcn_workitem_id_x(); asm volatile("" : "+v"(t)); return t; }
DI float bf2f(bf16_t v) { return __uint_as_float(((unsigned)v) << 16); }
DI bf16_t f2bf(float x) { unsigned u = __float_as_uint(x); u += 0x7fffu + ((u >> 16) & 1u); return (bf16_t)(u >> 16); }
DI unsigned pack2(float lo, float hi) { return (unsigned)f2bf(lo) | ((unsigned)f2bf(hi) << 16); }
DI float lo16(unsigned u) { return __uint_as_float(u << 16); }
DI float hi16(unsigned u) { return __uint_as_float(u & 0xffff0000u); }
DI float sigmoidf_(float x) { return 1.f / (1.f + __expf(-x)); }
template <int CTRL> DI float dppf(float x) { return __int_as_float(__builtin_amdgcn_update_dpp(0, __float_as_int(x), CTRL, 0xF, 0xF, true)); }
DI float allreduce16(float x) { x += dppf<0xB1>(x); x += dppf<0x4E>(x); x += dppf<0x141>(x); x += dppf<0x140>(x); return x; }
DI float allreduce32(float x) { x = allreduce16(x); x += __shfl_xor(x, 16); return x; }
DI float allreduce64(float x) { x = allreduce32(x); x += __shfl_xor(x, 32); return x; }

enum { EPI_WIN = 0, EPI_LW, EPI_LA, EPI_POSTB, EPI_RES, EPI_UP, EPI_PP, EPI_GATE, EPI_QKV };
struct GA {
  const void* A; int lda; int ksplit; int koff2;
  const bf16_t* Bt; int K; int N; int MT; int m_base;
  const float* rss_in; int nparts; float* rss_out;
  const float* resid; float* xout; bf16_t* xb;
  bf16_t* outb;
  const float* c0; const float* c1; const float* c2;
  const float* pp; const bf16_t* auxb; bf16_t* aux2; const float* auxf;
};

template <int EPI, bool AF32>
DI void gemm_tile(const GA& g, int t, char* lds) {
  const int tid = tidx(), wv = tid >> 6, l = tid & 63, hl = l >> 5, lq = l & 31, wm = wv >> 1, wn = wv & 1;
  constexpr int MF = AF32 ? 2 : 4;
  constexpr int TM = MF * 64;
  const int NT = g.N >> 7;
  const int x = t & 7, j = t >> 3, MTx = (AF32 ? g.MT : (g.MT >> 1)) >> 3;
  const int G = MTx < 8 ? MTx : 8;
  const int mi = j % G, j1 = j / G, nt = j1 % NT, mg = j1 / NT;
  const int mt = x * MTx + mg * G + mi;
  const int m0 = g.m_base + mt * TM, n0 = nt * 128;
  const int K = g.K, nk = K >> 6;
  f32x16 acc[MF][2];
#pragma unroll
  for (int a = 0; a < MF; ++a)
#pragma unroll
    for (int b = 0; b < 2; ++b)
#pragma unroll
      for (int i = 0; i < 16; ++i) acc[a][b][i] = 0.f;
  if constexpr (AF32) {
  u32x4 ra0[4], rb0[4], ra1[4], rb1[4];
  const int lrow = tid >> 3, lkc = tid & 7;
  const char* Ag = (const char*)g.A + ((size_t)(m0 + lrow) * g.lda) * (AF32 ? 4 : 2) + lkc * (AF32 ? 32 : 16);
  const char* Bg = (const char*)(g.Bt + (size_t)(n0 + lrow) * K + lkc * 8);
  const size_t astep = (size_t)32 * g.lda * (AF32 ? 4 : 2), bstep = (size_t)32 * K * 2;
#define GLOAD(kt, RA, RB) { const int k0_ = (kt) << 6; const int acol_ = (k0_ < g.ksplit) ? k0_ : k0_ + g.koff2; \
    _Pragma("unroll") for (int i = 0; i < 4; ++i) { \
      if (AF32) { const float* ap_ = (const float*)(Ag + i * astep) + acol_; const f32x4 v0_ = *(const f32x4*)ap_, v1_ = *(const f32x4*)(ap_ + 4); \
        RA[i][0] = pack2(v0_[0], v0_[1]); RA[i][1] = pack2(v0_[2], v0_[3]); RA[i][2] = pack2(v1_[0], v1_[1]); RA[i][3] = pack2(v1_[2], v1_[3]); } \
      else RA[i] = *(const u32x4*)(Ag + i * astep + (size_t)acol_ * 2); \
      RB[i] = *(const u32x4*)(Bg + i * bstep + (size_t)k0_ * 2); } }
  const int lsoff = lrow * LSTR + lkc * 16;
#define LSTORE(buf, RA, RB) { char* base_ = lds + (buf) * GSTAGE + lsoff; \
    _Pragma("unroll") for (int i = 0; i < 4; ++i) { *(u32x4*)(base_ + i * 32 * LSTR) = RA[i]; *(u32x4*)(base_ + 128 * LSTR + i * 32 * LSTR) = RB[i]; } }
  const int aoff = (wm * 64 + lq) * LSTR + hl * 16, boff = (128 + wn * 64 + lq) * LSTR + hl * 16;
#define COMPUTE(buf) { const char* Ab_ = lds + (buf) * GSTAGE + aoff; const char* Bb_ = lds + (buf) * GSTAGE + boff; \
    _Pragma("unroll") for (int ks = 0; ks < 4; ++ks) { bf16x8 af_[2], bf_[2]; \
      _Pragma("unroll") for (int f = 0; f < 2; ++f) { af_[f] = *(const bf16x8*)(Ab_ + f * 32 * LSTR + ks * 32); bf_[f] = *(const bf16x8*)(Bb_ + f * 32 * LSTR + ks * 32); } \
      _Pragma("unroll") for (int a = 0; a < 2; ++a) _Pragma("unroll") for (int b = 0; b < 2; ++b) acc[a][b] = MFMA32(af_[a], bf_[b], acc[a][b]); } }
  GLOAD(0, ra0, rb0);
  if (nk > 1) GLOAD(1, ra1, rb1);
  LSTORE(0, ra0, rb0);
  __syncthreads();
  for (int kt = 0; kt < nk; kt += 2) {
    if (kt + 2 < nk) GLOAD(kt + 2, ra0, rb0);
    __builtin_amdgcn_sched_barrier(0);
    COMPUTE(0);
    __builtin_amdgcn_sched_barrier(0);
    if (kt + 1 < nk) LSTORE(1, ra1, rb1);
    __syncthreads();
    if (kt + 1 >= nk) break;
    if (kt + 3 < nk) GLOAD(kt + 3, ra1, rb1);
    __builtin_amdgcn_sched_barrier(0);
    COMPUTE(1);
    __builtin_amdgcn_sched_barrier(0);
    if (kt + 2 < nk) LSTORE(0, ra0, rb0);
    __syncthreads();
  }
#undef GLOAD
#undef LSTORE
#undef COMPUTE
  } else {
    const int nk32 = K >> 5;
    const int srow = l >> 2, sc = ((l & 3) ^ ((l >> 4) & 3)) * 8;
    const bf16_t* Ap0 = (const bf16_t*)g.A + (size_t)(m0 + 16 * wv + srow) * g.lda + sc;
    const size_t a64 = (size_t)64 * g.lda;
    const bf16_t* Bp0 = g.Bt + (size_t)(n0 + 16 * wv + srow) * K + sc;
    const bf16_t* Bp1 = Bp0 + (size_t)64 * K;
    char* ldst = lds + wv * 1024 + l * 16;
#define GSTAGE_ISSUE(tt) { const int k0_ = (tt) << 5; const int acol_ = (k0_ < g.ksplit) ? k0_ : k0_ + g.koff2; char* d_ = ldst + ((tt) % 3) * 24576; \
      __builtin_amdgcn_global_load_lds((const unsigned*)(Ap0 + acol_), (LAS unsigned*)(d_), 16, 0, 0); \
      __builtin_amdgcn_global_load_lds((const unsigned*)(Ap0 + a64 + acol_), (LAS unsigned*)(d_ + 4096), 16, 0, 0); \
      __builtin_amdgcn_global_load_lds((const unsigned*)(Ap0 + 2 * a64 + acol_), (LAS unsigned*)(d_ + 8192), 16, 0, 0); \
      __builtin_amdgcn_global_load_lds((const unsigned*)(Ap0 + 3 * a64 + acol_), (LAS unsigned*)(d_ + 12288), 16, 0, 0); \
      __builtin_amdgcn_global_load_lds((const unsigned*)(Bp0 + k0_), (LAS unsigned*)(d_ + 16384), 16, 0, 0); \
      __builtin_amdgcn_global_load_lds((const unsigned*)(Bp1 + k0_), (LAS unsigned*)(d_ + 20480), 16, 0, 0); }
    const int fsw = (lq >> 2) & 3;
    const int a0off = (wm * 128 + lq) * 64 + ((hl ^ fsw) << 4), b0off = 16384 + (wn * 64 + lq) * 64 + ((hl ^ fsw) << 4);
    WAIT_V(0);
    __syncthreads();
    GSTAGE_ISSUE(0);
    if (nk32 > 1) GSTAGE_ISSUE(1);
    int st3 = 0;
#define GL1(i_, tt) { const int k0_ = (tt) << 5; const int acol_ = (k0_ < g.ksplit) ? k0_ : k0_ + g.koff2; char* d_ = ldst + ((tt) % 3) * 24576; \
      if (i_ < 4) __builtin_amdgcn_global_load_lds((const unsigned*)(Ap0 + i_ * a64 + acol_), (LAS unsigned*)(d_ + i_ * 4096), 16, 0, 0); \
      else if (i_ == 4) __builtin_amdgcn_global_load_lds((const unsigned*)(Bp0 + k0_), (LAS unsigned*)(d_ + 16384), 16, 0, 0); \
      else __builtin_amdgcn_global_load_lds((const unsigned*)(Bp1 + k0_), (LAS unsigned*)(d_ + 20480), 16, 0, 0); }
#define BODY(ISSUE) { \
        bf16x8 a0_[4], b0_[2], a1_[4], b1_[2]; \
        _Pragma("unroll") for (int f = 0; f < 4; ++f) a0_[f] = *(const bf16x8*)(sb_ + a0off + f * 2048); \
        b0_[0] = *(const bf16x8*)(sb_ + b0off); b0_[1] = *(const bf16x8*)(sb_ + b0off + 2048); \
        _Pragma("unroll") for (int f = 0; f < 4; ++f) a1_[f] = *(const bf16x8*)(sb_ + (a0off ^ 32) + f * 2048); \
        b1_[0] = *(const bf16x8*)(sb_ + (b0off ^ 32)); b1_[1] = *(const bf16x8*)(sb_ + (b0off ^ 32) + 2048); \
        __builtin_amdgcn_sched_barrier(0); \
        _Pragma("unroll") for (int a = 0; a < 4; ++a) _Pragma("unroll") for (int b = 0; b < 2; ++b) { \
          acc[a][b] = MFMA32(a0_[a], b0_[b], acc[a][b]); \
          if (ISSUE && (a * 2 + b) < 6) { GL1((a * 2 + b), t + 2); } \
          __builtin_amdgcn_sched_barrier(0); } \
        _Pragma("unroll") for (int a = 0; a < 4; ++a) _Pragma("unroll") for (int b = 0; b < 2; ++b) acc[a][b] = MFMA32(a1_[a], b1_[b], acc[a][b]); }
    for (int t = 0; t < nk32; ++t) {
      if (t + 1 < nk32) WAIT_V(6); else WAIT_V(0);
      RAW_BARRIER();
      const char* sb_ = lds + st3 * 24576;
      st3 = (st3 == 2) ? 0 : st3 + 1;
      if (t + 2 < nk32) BODY(true) else BODY(false)
    }
#undef BODY
#undef GL1
    WAIT_L0();
    __syncthreads();
#undef GSTAGE_ISSUE
  }
  float* rs = (float*)(lds + AUXOFF);
  if (EPI == EPI_WIN || EPI == EPI_UP || EPI == EPI_QKV || EPI == EPI_GATE) {
    if (tid < TM) {
      float s = 0.f;
      for (int q = 0; q < g.nparts; ++q) s += g.rss_in[(size_t)q * M + m0 + tid];
      rs[tid] = rsqrtf(s * (1.f / 1024.f) + 1e-6f);
    }
    __syncthreads();
  }
#pragma unroll
  for (int mf = 0; mf < MF; ++mf) {
#pragma unroll
    for (int i = 0; i < 16; ++i) {
      const int rl = wm * (MF * 32) + mf * 32 + (i & 3) + 8 * (i >> 2) + 4 * hl;
      const int row = m0 + rl;
      const int colb = n0 + wn * 64 + lq;
      float v0 = acc[mf][0][i], v1 = acc[mf][1][i];
      if (EPI == EPI_WIN) {
        const float r = rs[rl]; v0 *= r; v1 *= r;
        float o0, o1;
        if (n0 < 512 || (n0 >= 1536 && n0 < 2048)) { o0 = v0 * sigmoidf_(v0); o1 = v1 * sigmoidf_(v1); }
        else if (n0 < 1024) {
          const float lb0 = g.c0[colb - 512], lb1 = g.c0[colb + 32 - 512];
          o0 = logf(lb0 + (1.f - lb0) * sigmoidf_(v0)); o1 = logf(lb1 + (1.f - lb1) * sigmoidf_(v1));
        } else { o0 = v0; o1 = v1; }
        const bf16_t b0 = f2bf(o0), b1 = f2bf(o1);
        g.outb[(size_t)row * 3840 + colb] = b0; g.outb[(size_t)row * 3840 + colb + 32] = b1;
        if (n0 >= 2048 && (row & 15) == 15) { bf16_t* bd = g.aux2 + (size_t)(row >> 4) * 1792 + (colb - 2048); bd[0] = b0; bd[32] = b1; }
      } else if (EPI == EPI_LW) {
        float z0 = -(g.c0[colb] + v0), z1 = -(g.c0[colb + 32] + v1);
        const float sp0 = z0 > 20.f ? z0 : log1pf(expf(z0)), sp1 = z1 > 20.f ? z1 : log1pf(expf(z1));
        g.outb[(size_t)row * 512 + colb] = f2bf(-expf(-sp0 - 0.5f)); g.outb[(size_t)row * 512 + colb + 32] = f2bf(-expf(-sp1 - 0.5f));
      } else if (EPI == EPI_LA) {
        g.outb[(size_t)row * 512 + colb] = f2bf(sigmoidf_(g.c0[colb] + v0)); g.outb[(size_t)row * 512 + colb + 32] = f2bf(sigmoidf_(g.c0[colb + 32] + v1));
      } else if (EPI == EPI_POSTB) {
        const float y0 = bf2f(g.auxb[(size_t)row * 512 + colb]), y1 = bf2f(g.auxb[(size_t)row * 512 + colb + 32]);
        const float s1 = allreduce32(y0 + y1) * (1.f / 64.f);
        const float d0 = y0 - s1, d1 = y1 - s1;
        const float var = allreduce32(d0 * d0 + d1 * d1) * (1.f / 64.f);
        const float rstd = rsqrtf(var + 64e-5f);
        const int head = (n0 >> 6) + wn;
        const float bon = g.auxf[(size_t)row * 8 + head];
        bf16_t* ur = g.outb + (size_t)row * 3840 + 2048;
        const float vv0 = bf2f(ur[1024 + colb]), vv1 = bf2f(ur[1024 + colb + 32]);
        const float o0 = (d0 * rstd * g.c0[colb] + g.c1[colb] + bon * vv0) * v0;
        const float o1 = (d1 * rstd * g.c0[colb + 32] + g.c1[colb + 32] + bon * vv1) * v1;
        ur[colb] = f2bf(o0); ur[colb + 32] = f2bf(o1);
      } else if (EPI == EPI_RES || EPI == EPI_GATE) {
        const size_t o = (size_t)row * 1024 + colb;
        float x0, x1;
        if (EPI == EPI_RES) { x0 = g.resid[o] + v0; x1 = g.resid[o + 32] + v1; }
        else {
          const float r = rs[rl];
          x0 = g.resid[o] + g.pp[o] * r * g.c0[colb] * sigmoidf_(v0);
          x1 = g.resid[o + 32] + g.pp[o + 32] * r * g.c0[colb + 32] * sigmoidf_(v1);
        }
        g.xout[o] = x0; g.xout[o + 32] = x1;
        g.xb[o] = f2bf(x0); g.xb[o + 32] = f2bf(x1);
        const float ss = allreduce32(x0 * x0 + x1 * x1);
        if (lq == 0) g.rss_out[(size_t)(nt * 2 + wn) * M + row] = ss;
      } else if (EPI == EPI_UP) {
        const float r = rs[rl];
        float a0 = fmaxf(v0 * r, 0.f), a1 = fmaxf(v1 * r, 0.f);
        g.outb[(size_t)row * 4096 + colb] = f2bf(a0 * a0); g.outb[(size_t)row * 4096 + colb + 32] = f2bf(a1 * a1);
      } else if (EPI == EPI_PP) {
        const size_t o = (size_t)row * 1024 + colb;
        g.xout[o] = v0; g.xout[o + 32] = v1;
        const float ss = allreduce32(v0 * v0 + v1 * v1);
        if (lq == 0) g.rss_out[(size_t)(nt * 2 + wn) * M + row] = ss;
      } else if (EPI == EPI_QKV) {
        const float r = rs[rl];
        g.outb[(size_t)row * 3072 + colb] = f2bf(v0 * r); g.outb[(size_t)row * 3072 + colb + 32] = f2bf(v1 * r);
      }
    }
  }
}

struct TJob { const float* src; bf16_t* dst; const float* gain; int K, N; };
DI void transpose_unit(const TJob& j, int unit, char* ldsc) {
  float* lds = (float*)ldsc;
  const int tid = tidx();
  const int nkt = j.K >> 6, kt = unit % nkt, nt = unit / nkt;
#pragma unroll
  for (int i = 0; i < 4; ++i) {
    const int r = (tid >> 4) + 16 * i, c4 = (tid & 15) * 4, k = kt * 64 + r;
    const f32x4 v = *(const f32x4*)(j.src + (size_t)k * j.N + nt * 64 + c4);
    const float gn = j.gain ? j.gain[k] : 1.f;
    lds[r * 65 + c4] = v[0] * gn; lds[r * 65 + c4 + 1] = v[1] * gn; lds[r * 65 + c4 + 2] = v[2] * gn; lds[r * 65 + c4 + 3] = v[3] * gn;
  }
  __syncthreads();
#pragma unroll
  for (int i = 0; i < 2; ++i) {
    const int n = (tid >> 3) + 32 * i, k8 = (tid & 7) * 8;
    u32x4 o;
    o[0] = pack2(lds[(k8 + 0) * 65 + n], lds[(k8 + 1) * 65 + n]); o[1] = pack2(lds[(k8 + 2) * 65 + n], lds[(k8 + 3) * 65 + n]);
    o[2] = pack2(lds[(k8 + 4) * 65 + n], lds[(k8 + 5) * 65 + n]); o[3] = pack2(lds[(k8 + 6) * 65 + n], lds[(k8 + 7) * 65 + n]);
    *(u32x4*)(j.dst + (size_t)(nt * 64 + n) * j.K + kt * 64 + k8) = o;
  }
  __syncthreads();
}
#define TJ(SRC, DST, GAIN, KK, NN) { const int n_ = ((KK) >> 6) * ((NN) >> 6); if (uu < n_) { TJob j_; j_.src = (SRC); j_.dst = (bf16_t*)(DST); j_.gain = (GAIN); j_.K = (KK); j_.N = (NN); transpose_unit(j_, uu, lds); return; } uu -= n_; }
DI void tjobs0(const Pm& p, int uu, char* lds) {
  char* ws = p.ws;
  TJ(p.in[4], ws + W_WIN, p.in[2], 1024, 3840)
  TJ(p.in[5], ws + W_WOUT, nullptr, 1024, 1024)
  TJ(p.in[23], ws + W_UP0, p.in[3], 1024, 4096)
  TJ(p.in[24], ws + W_DN0, nullptr, 4096, 1024)
  TJ(p.in[25], ws + W_PPJ0, nullptr, 256, 1024)
  TJ(p.in[27], ws + W_PGT0, nullptr, 1024, 1024)
  TJ(p.in[10], ws + W_W2, nullptr, 64, 512)
  TJ(p.in[12], ws + W_A2, nullptr, 64, 512)
  TJ(p.in[13], ws + W_G2, nullptr, 128, 512)
}
DI void tjobs1(const Pm& p, int uu, char* lds) {
  char* ws = p.ws;
  TJ(p.in[19], ws + W_QKV, p.in[2] + 1024, 1024, 3072)
  TJ(p.in[20], ws + W_WO, nullptr, 1024, 1024)
  TJ(p.in[23] + (size_t)1024 * 4096, ws + W_UP1, p.in[3] + 1024, 1024, 4096)
  TJ(p.in[24] + (size_t)4096 * 1024, ws + W_DN1, nullptr, 4096, 1024)
  TJ(p.in[25] + (size_t)256 * 1024, ws + W_PPJ1, nullptr, 256, 1024)
  TJ(p.in[27] + (size_t)1024 * 1024, ws + W_PGT1, nullptr, 1024, 1024)
}
DI void phase0(const Pm& p, char* lds) {
  char* ws = p.ws;
  constexpr int NT_UNITS = 960 + 256 + 1024 + 1024 + 64 + 256 + 8 + 8 + 16;
  constexpr int NX_UNITS = 256;
  const int total = NT_UNITS + NX_UNITS + 1;
  const int tid = tidx(), wv = tid >> 6, l = tid & 63;
  for (int u = blockIdx.x; u < total; u += gridDim.x) {
    if (u >= NX_UNITS && u < NX_UNITS + NT_UNITS) { tjobs0(p, u - NX_UNITS, lds); }
    else if (u < NX_UNITS) {
      const int r0 = u * 64 + wv * 16;
      const float* x = p.in[0]; bf16_t* xb = (bf16_t*)(ws + XB_A); float* rss = (float*)(ws + RSS_X0);
      for (int r = r0; r < r0 + 16; ++r) {
        float ss = 0.f;
#pragma unroll
        for (int q = 0; q < 4; ++q) {
          const f32x4 v = *(const f32x4*)(x + (size_t)r * 1024 + q * 256 + l * 4);
          ss += v[0] * v[0] + v[1] * v[1] + v[2] * v[2] + v[3] * v[3];
          u32x2 o; o[0] = pack2(v[0], v[1]); o[1] = pack2(v[2], v[3]);
          *(u32x2*)(xb + (size_t)r * 1024 + q * 256 + l * 4) = o;
        }
        ss = allreduce64(ss);
        if (l == 0) rss[r] = ss;
      }
    } else {
      const float* hl = p.in[6]; float* lb = (float*)(ws + LBOFF);
      for (int c = tid; c < 512; c += 256) {
        const float a0 = hl[c], a1 = hl[512 + c], a2 = hl[1024 + c];
        const float mx = fmaxf(a0, fmaxf(a1, a2));
        const float e0 = expf(a0 - mx), e1 = expf(a1 - mx), e2 = expf(a2 - mx);
        lb[c] = e0 / (e0 + e1 + e2);
      }
    }
  }
}

DI void phase_w1_unit(const Pm& p, int u, char* lds) {
  char* ws = p.ws;
  constexpr int NT_UNITS = 768 + 256 + 1024 + 1024 + 64 + 256;
  if (u < NT_UNITS) { tjobs1(p, u, lds); }
  else {
    const int idx0 = (u - NT_UNITS) * 256 + tidx();
    const int s = idx0 >> 6, i = idx0 & 63;
    const float inv_freq = powf(10000.f, -(float)i / 64.f);
    const float ang = (float)s * inv_freq;
    float2 cs; cs.x = (float)cos((double)ang); cs.y = (float)sin((double)ang);
    ((float2*)(ws + ROPE))[idx0] = cs;
  }
}
constexpr int W1_UNITS = 3392 + 1024;

DI void tokshift_unit(const Pm& p, int tile) {
  char* ws = p.ws;
  const int l = tidx() & 63;
  bf16_t* U = (bf16_t*)(ws + U_OFF);
  const bf16_t* bnd = (const bf16_t*)(ws + BND);
  const float* mu = p.in[8];
  const int t0 = tile * 16;
  u32x2 cur[7], prv[7];
#pragma unroll
  for (int j = 0; j < 7; ++j) cur[j] = *(const u32x2*)(U + (size_t)(t0 + 15) * 3840 + 2048 + j * 256 + l * 4);
  for (int r = 15; r >= 0; --r) {
    const bool zero = (r == 0) && ((t0 & 4095) == 0);
    const bf16_t* pr = (r > 0) ? (U + (size_t)(t0 + r - 1) * 3840 + 2048) : (bnd + (size_t)(tile - 1) * 1792);
#pragma unroll
    for (int j = 0; j < 7; ++j) { if (zero) { prv[j][0] = 0; prv[j][1] = 0; } else prv[j] = *(const u32x2*)(pr + j * 256 + l * 4); }
#pragma unroll
    for (int j = 0; j < 7; ++j) {
      const int c = j * 256 + l * 4;
      const f32x4 m = *(const f32x4*)(mu + c);
      float o[4];
      o[0] = lo16(cur[j][0]); o[1] = hi16(cur[j][0]); o[2] = lo16(cur[j][1]); o[3] = hi16(cur[j][1]);
      const float q0 = lo16(prv[j][0]), q1 = hi16(prv[j][0]), q2 = lo16(prv[j][1]), q3 = hi16(prv[j][1]);
      o[0] += (q0 - o[0]) * m[0]; o[1] += (q1 - o[1]) * m[1]; o[2] += (q2 - o[2]) * m[2]; o[3] += (q3 - o[3]) * m[3];
      if (j == 6) {
        if (l < 16) { for (int e = 0; e < 4; ++e) o[e] = tanhf(o[e]); }
        else if (l >= 32) { for (int e = 0; e < 4; ++e) o[e] = sigmoidf_(o[e]); }
      }
      u32x2 w; w[0] = pack2(o[0], o[1]); w[1] = pack2(o[2], o[3]);
      *(u32x2*)(U + (size_t)(t0 + r) * 3840 + 2048 + c) = w;
      cur[j] = prv[j];
    }
  }
}

DI void rwkv_unit(const Pm& p, int u, char* lds) {
  char* ws = p.ws;
  const int bh = u & 31, qtr = u >> 5, b = bh >> 3, h = bh & 7;
  const int tid = tidx(), wv = tid >> 6, l = tid & 63, rg = l >> 4, c = l & 15;
  const int row = qtr * 16 + wv * 4 + rg;
  const int tk = tid >> 4, cg = tid & 15, hc = h * 64 + cg * 4;
  const bf16_t* U = (const bf16_t*)(ws + U_OFF);
  const bf16_t* AA = (const bf16_t*)(ws + AARR);
  const bf16_t* LD = (const bf16_t*)(ws + LOGD);
  bf16_t* Y = (bf16_t*)(ws + Y_OFF);
  float* bonus = (float*)(ws + BONUS);
  const f32x4 kkc = *(const f32x4*)(p.in[14] + hc), kac = *(const f32x4*)(p.in[15] + hc), rkc = *(const f32x4*)(p.in[16] + hc);
  float S0 = 0.f, S1 = 0.f, S2 = 0.f, S3 = 0.f;
  u32x2 gr, gk, gv, ga, gl;
  auto gload = [&](int ch) {
    const size_t tok = (size_t)b * 4096 + ch * 16 + tk;
    const bf16_t* up = U + tok * 3840 + 2048 + hc;
    gr = *(const u32x2*)up; gk = *(const u32x2*)(up + 512); gv = *(const u32x2*)(up + 1024);
    ga = *(const u32x2*)(AA + tok * 512 + hc); gl = *(const u32x2*)(LD + tok * 512 + hc);
  };
  auto stage = [&](int ch, int buf) {
    char* base = lds + buf * 24576 + tk * 256 + cg * 16;
    f32x4 r, k, v, a, ld;
    r[0] = lo16(gr[0]); r[1] = hi16(gr[0]); r[2] = lo16(gr[1]); r[3] = hi16(gr[1]);
    k[0] = lo16(gk[0]); k[1] = hi16(gk[0]); k[2] = lo16(gk[1]); k[3] = hi16(gk[1]);
    v[0] = lo16(gv[0]); v[1] = hi16(gv[0]); v[2] = lo16(gv[1]); v[3] = hi16(gv[1]);
    a[0] = lo16(ga[0]); a[1] = hi16(ga[0]); a[2] = lo16(ga[1]); a[3] = hi16(ga[1]);
    ld[0] = lo16(gl[0]); ld[1] = hi16(gl[0]); ld[2] = lo16(gl[1]); ld[3] = hi16(gl[1]);
    f32x4 kx, kk, kf, kka, w;
    float ss = 0.f, bon = 0.f;
#pragma unroll
    for (int e = 0; e < 4; ++e) { kx[e] = k[e] * kkc[e]; ss += kx[e] * kx[e]; }
    ss = allreduce16(ss);
    const float inv = 1.f / fmaxf(sqrtf(ss), 1e-12f);
#pragma unroll
    for (int e = 0; e < 4; ++e) {
      kk[e] = kx[e] * inv; kf[e] = k[e] * (1.f + (a[e] - 1.f) * kac[e]); kka[e] = kk[e] * a[e]; w[e] = __expf(ld[e]);
      bon += r[e] * kf[e] * rkc[e];
    }
    bon = allreduce16(bon);
    if (qtr == 0 && cg == 0) bonus[((size_t)b * 4096 + ch * 16 + tk) * 8 + h] = bon;
    *(f32x4*)(base) = w; *(f32x4*)(base + 4096) = kk; *(f32x4*)(base + 8192) = kka; *(f32x4*)(base + 12288) = kf; *(f32x4*)(base + 16384) = r; *(f32x4*)(base + 20480) = v;
  };
  gload(0); stage(0, 0); __syncthreads();
  for (int ch = 0; ch < 256; ++ch) {
    if (ch + 1 < 256) gload(ch + 1);
    const char* base = lds + (ch & 1) * 24576;
    float ykeep = 0.f;
#pragma unroll 4
    for (int s = 0; s < 16; ++s) {
      const char* bs = base + s * 256 + c * 16;
      const f32x4 w = *(const f32x4*)(bs), kk = *(const f32x4*)(bs + 4096), kka = *(const f32x4*)(bs + 8192), k = *(const f32x4*)(bs + 12288), r = *(const f32x4*)(bs + 16384);
      const float v = *(const float*)(base + 20480 + s * 256 + row * 4);
      float d = S0 * kk[0] + S1 * kk[1] + S2 * kk[2] + S3 * kk[3];
      d = allreduce16(d);
      const float sa = -d;
      S0 = S0 * w[0] + sa * kka[0] + v * k[0]; S1 = S1 * w[1] + sa * kka[1] + v * k[1];
      S2 = S2 * w[2] + sa * kka[2] + v * k[2]; S3 = S3 * w[3] + sa * kka[3] + v * k[3];
      float y = S0 * r[0] + S1 * r[1] + S2 * r[2] + S3 * r[3];
      y = allreduce16(y);
      if (c == s) ykeep = y;
    }
    Y[((size_t)b * 4096 + ch * 16 + c) * 512 + h * 64 + row] = f2bf(ykeep);
    if (ch + 1 < 256) stage(ch + 1, (ch + 1) & 1);
    __syncthreads();
  }
}

DI void hgrn_unit(const Pm& p, int u, char* lds) {
  char* ws = p.ws;
  const int bh = u & 15, vs = u >> 4, b = bh >> 2, h = bh & 3;
  const int tid = tidx(), wv = tid >> 6, l = tid & 63, rg = l >> 4, c = l & 15;
  const int vcol = wv * 4 + rg;
  const int tk = tid >> 4, cg = tid & 15;
  const bf16_t* U = (const bf16_t*)(ws + U_OFF);
  bf16_t* OA = (bf16_t*)(ws + OA_OFF);
  float S[8];
#pragma unroll
  for (int e = 0; e < 8; ++e) S[e] = 0.f;
  u32x4 gq, gf; bf16_t gvv;
  auto gload = [&](int ch) {
    const size_t tok = (size_t)b * 4096 + ch * 16 + tk;
    const bf16_t* up = U + tok * 3840 + h * 128;
    gq = *(const u32x4*)(up + cg * 8); gf = *(const u32x4*)(up + 512 + cg * 8); gvv = up[1024 + vs * 16 + cg];
  };
  auto stage = [&](int buf) {
    char* base = lds + buf * 25600;
    f32x4 f0, f1, k0, k1, q0, q1;
#pragma unroll
    for (int e = 0; e < 2; ++e) {
      f0[2 * e] = __expf(lo16(gf[e])); f0[2 * e + 1] = __expf(hi16(gf[e])); f1[2 * e] = __expf(lo16(gf[2 + e])); f1[2 * e + 1] = __expf(hi16(gf[2 + e]));
      q0[2 * e] = lo16(gq[e]); q0[2 * e + 1] = hi16(gq[e]); q1[2 * e] = lo16(gq[2 + e]); q1[2 * e + 1] = hi16(gq[2 + e]);
    }
#pragma unroll
    for (int e = 0; e < 4; ++e) { k0[e] = 1.f - f0[e]; k1[e] = 1.f - f1[e]; }
    char* w = base + tk * 512 + cg * 32;
    *(f32x4*)(w) = f0; *(f32x4*)(w + 16) = f1; *(f32x4*)(w + 8192) = k0; *(f32x4*)(w + 8192 + 16) = k1; *(f32x4*)(w + 16384) = q0; *(f32x4*)(w + 16384 + 16) = q1;
    *(float*)(base + 24576 + tk * 64 + cg * 4) = bf2f(gvv);
  };
  gload(0); stage(0); __syncthreads();
  for (int ch = 0; ch < 256; ++ch) {
    if (ch + 1 < 256) gload(ch + 1);
    const char* base = lds + (ch & 1) * 25600;
    float ykeep = 0.f;
#pragma unroll 4
    for (int s = 0; s < 16; ++s) {
      const char* bs = base + s * 512 + c * 16;
      const f32x4 f0 = *(const f32x4*)(bs), f1 = *(const f32x4*)(bs + 256), k0 = *(const f32x4*)(bs + 8192), k1 = *(const f32x4*)(bs + 8192 + 256), q0 = *(const f32x4*)(bs + 16384), q1 = *(const f32x4*)(bs + 16384 + 256);
      const float v = *(const float*)(base + 24576 + s * 64 + vcol * 4);
      float a0 = 0.f, a1 = 0.f;
#pragma unroll
      for (int e = 0; e < 4; ++e) {
        S[e] = f0[e] * S[e] + k0[e] * v; a0 += S[e] * q0[e];
        S[4 + e] = f1[e] * S[4 + e] + k1[e] * v; a1 += S[4 + e] * q1[e];
      }
      const float y = allreduce16(a0 + a1);
      if (c == s) ykeep = y;
    }
    OA[((size_t)b * 4096 + ch * 16 + c) * 512 + h * 128 + vs * 16 + vcol] = f2bf(ykeep);
    if (ch + 1 < 256) stage((ch + 1) & 1);
    __syncthreads();
  }
}

DI void oapost_unit(const Pm& p, int unit) {
  char* ws = p.ws;
  const int wv = tidx() >> 6, l = tidx() & 63;
  const bf16_t* OA = (const bf16_t*)(ws + OA_OFF);
  bf16_t* U = (bf16_t*)(ws + U_OFF);
  const float* on = p.in[7] + l * 8;
  const f32x4 g0 = *(const f32x4*)on, g1 = *(const f32x4*)(on + 4);
  for (int r = 0; r < 16; ++r) {
    const size_t tok = (size_t)unit * 64 + wv * 16 + r;
    const u32x4 o = *(const u32x4*)(OA + tok * 512 + l * 8);
    const u32x4 hg = *(const u32x4*)(U + tok * 3840 + 1536 + l * 8);
    float v[8], gt[8];
#pragma unroll
    for (int e = 0; e < 4; ++e) { v[2 * e] = lo16(o[e]); v[2 * e + 1] = hi16(o[e]); gt[2 * e] = lo16(hg[e]); gt[2 * e + 1] = hi16(hg[e]); }
    float ss = 0.f;
#pragma unroll
    for (int e = 0; e < 8; ++e) ss += v[e] * v[e];
    ss = allreduce16(ss);
    const float inv = rsqrtf(ss * (1.f / 128.f) + 1e-6f);
    u32x4 w;
    w[0] = pack2(v[0] * inv * g0[0] * gt[0], v[1] * inv * g0[1] * gt[1]); w[1] = pack2(v[2] * inv * g0[2] * gt[2], v[3] * inv * g0[3] * gt[3]);
    w[2] = pack2(v[4] * inv * g1[0] * gt[4], v[5] * inv * g1[1] * gt[5]); w[3] = pack2(v[6] * inv * g1[2] * gt[6], v[7] * inv * g1[3] * gt[7]);
    *(u32x4*)(U + tok * 3840 + l * 8) = w;
  }
}

DI void attnprep_unit(const Pm& p, int unit, char* lds) {
  char* ws = p.ws;
  const int bh = unit & 31, blk = unit >> 5, b = bh >> 3, h = bh & 7;
  const int tid = tidx(), wv = tid >> 6, l = tid & 63;
  bf16_t* qkv = (bf16_t*)(ws + QKV);
  bf16_t* vt = (bf16_t*)(ws + VT);
  float* kmean = (float*)(ws + KMEAN);
  const float2* rope = (const float2*)(ws + ROPE);
  const float gq0 = p.in[21][l], gq1 = p.in[21][l + 64], gk0 = p.in[22][l], gk1 = p.in[22][l + 64];
  float ks0 = 0.f, ks1 = 0.f;
  for (int it4 = 0; it4 < 16; ++it4) {
    float xq0[4], xq1[4], xk0[4], xk1[4]; float2 csv[4];
#pragma unroll
    for (int u = 0; u < 4; ++u) {
      const int s = blk * 256 + wv * 64 + it4 * 4 + u;
      const size_t rowo = ((size_t)b * 4096 + s) * 3072;
      const bf16_t* qp = qkv + rowo + h * 128; const bf16_t* kp = qkv + rowo + 1024 + h * 128;
      xq0[u] = bf2f(qp[l]); xq1[u] = bf2f(qp[l + 64]); xk0[u] = bf2f(kp[l]); xk1[u] = bf2f(kp[l + 64]);
      csv[u] = rope[s * 64 + l];
    }
#pragma unroll
    for (int u = 0; u < 4; ++u) {
      const int s = blk * 256 + wv * 64 + it4 * 4 + u;
      const size_t rowo = ((size_t)b * 4096 + s) * 3072;
      const float2 cs = csv[u];
      {
        bf16_t* qp = qkv + rowo + h * 128;
        float x0 = xq0[u], x1 = xq1[u];
        const float ss = allreduce64(x0 * x0 + x1 * x1);
        const float inv = rsqrtf(ss * (1.f / 128.f) + 1e-6f);
        x0 *= inv * gq0; x1 *= inv * gq1;
        const float o0 = x0 * cs.x - x1 * cs.y, o1 = x1 * cs.x + x0 * cs.y;
        qp[l] = f2bf(o0 * QSCALE); qp[l + 64] = f2bf(o1 * QSCALE);
      }
      {
        bf16_t* kp = qkv + rowo + 1024 + h * 128;
        float x0 = xk0[u], x1 = xk1[u];
        const float ss = allreduce64(x0 * x0 + x1 * x1);
        const float inv = rsqrtf(ss * (1.f / 128.f) + 1e-6f);
        x0 *= inv * gk0; x1 *= inv * gk1;
        const float o0 = x0 * cs.x - x1 * cs.y, o1 = x1 * cs.x + x0 * cs.y;
        ks0 += o0; ks1 += o1;
        kp[l] = f2bf(o0); kp[l + 64] = f2bf(o1);
      }
    }
  }
  float* red = (float*)lds;
  red[wv * 128 + l] = ks0; red[wv * 128 + 64 + l] = ks1;
  __syncthreads();
  if (tid < 128) kmean[((size_t)bh * 16 + blk) * 128 + tid] = (red[tid] + red[128 + tid] + red[256 + tid] + red[384 + tid]) * (1.f / 256.f);
  __syncthreads();
  for (int st = 0; st < 4; ++st) {
    const size_t tokbase = (size_t)b * 4096 + blk * 256 + st * 64;
#pragma unroll
    for (int i = 0; i < 4; ++i) {
      const int c = tid + 256 * i, r = c >> 4, ch = c & 15;
      *(u32x4*)(lds + r * 272 + ch * 16) = *(const u32x4*)(qkv + (tokbase + r) * 3072 + 2048 + h * 128 + ch * 8);
    }
    __syncthreads();
#pragma unroll
    for (int i = 0; i < 4; ++i) {
      const int d = tid & 127, t8 = (tid >> 7) + 2 * i;
      unsigned short e[8];
#pragma unroll
      for (int j = 0; j < 8; ++j) e[j] = *(const unsigned short*)(lds + (t8 * 8 + j) * 272 + d * 2);
      u32x4 o;
      o[0] = e[0] | ((unsigned)e[1] << 16); o[1] = e[2] | ((unsigned)e[3] << 16); o[2] = e[4] | ((unsigned)e[5] << 16); o[3] = e[6] | ((unsigned)e[7] << 16);
      *(u32x4*)(vt + ((size_t)bh * 128 + d) * 4096 + blk * 256 + st * 64 + t8 * 8) = o;
    }
    __syncthreads();
  }
}

constexpr int KSTR = 272, VSTR = 136, ASTAGE = 64 * KSTR + 128 * VSTR;
DI void attn_unit(const Pm& p, int unit, char* lds) {
  char* ws = p.ws;
  const int qt = 31 - (unit >> 5), bh = unit & 31, b = bh >> 3, h = bh & 7;
  const int tid = tidx(), wv = tid >> 6, l = tid & 63, hl = l >> 5, lq = l & 31;
  const int qb = qt >> 1;
  const size_t tok0 = (size_t)b * 4096 + qt * 128;
  const int myq = qt * 128 + wv * 32 + lq;
  bf16_t* qkv = (bf16_t*)(ws + QKV);
  const bf16_t* vt = (const bf16_t*)(ws + VT);
  const float* kmean = (const float*)(ws + KMEAN);
  const float NEG = -__builtin_inff();
  bf16x8 qf[8];
  {
    const bf16_t* qp = qkv + (tok0 + wv * 32 + lq) * 3072 + h * 128 + hl * 8;
#pragma unroll
    for (int ks = 0; ks < 8; ++ks) qf[ks] = *(const bf16x8*)(qp + ks * 16);
  }
  unsigned selmask = 0;
  unsigned* bm = (unsigned*)(lds + AUXOFF + 512);
  if (tid == 0) *bm = 0;
  if (qb > 0) {
    float* km = (float*)lds;
    for (int i = tid; i < qb * 128; i += 256) km[i] = kmean[(size_t)bh * 16 * 128 + i];
    __syncthreads();
    if (qb <= 3) selmask = (1u << qb) - 1u;
    else {
      float b0 = NEG, b1 = NEG, b2 = NEG; int i0 = 0, i1 = 0, i2 = 0;
      for (int n = 0; n < qb; ++n) {
        float gsum = 0.f;
#pragma unroll
        for (int ks = 0; ks < 8; ++ks) {
          const float* kr = km + n * 128 + ks * 16 + hl * 8;
#pragma unroll
          for (int j = 0; j < 8; ++j) gsum += bf2f((bf16_t)qf[ks][j]) * kr[j];
        }
        gsum += __shfl_xor(gsum, 32);
        if (gsum > b0) { b2 = b1; i2 = i1; b1 = b0; i1 = i0; b0 = gsum; i0 = n; }
        else if (gsum > b1) { b2 = b1; i2 = i1; b1 = gsum; i1 = n; }
        else if (gsum > b2) { b2 = gsum; i2 = n; }
      }
      selmask = (1u << i0) | (1u << i1) | (1u << i2);
    }
  }
  __syncthreads();
  if (selmask) atomicOr(bm, selmask);
  __syncthreads();
  const unsigned blkmask = *bm;
  const int own_tiles = (qt & 1) ? 4 : 2;
  int n = 0, kt = 0;
  while (n < qb && !((blkmask >> n) & 1u)) ++n;
  u32x4 rk[4], rv[4];
  auto gload = [&](int nn, int kk) {
    const int key0 = nn * 256 + kk * 64;
#pragma unroll
    for (int i = 0; i < 4; ++i) {
      const int c = tid + 256 * i;
      rk[i] = *(const u32x4*)(qkv + ((size_t)b * 4096 + key0 + (c >> 4)) * 3072 + 1024 + h * 128 + (c & 15) * 8);
      rv[i] = *(const u32x4*)(vt + ((size_t)bh * 128 + (c >> 3)) * 4096 + key0 + (c & 7) * 8);
    }
  };
  auto lstore = [&](int buf) {
    char* base = lds + buf * ASTAGE;
#pragma unroll
    for (int i = 0; i < 4; ++i) {
      const int c = tid + 256 * i;
      *(u32x4*)(base + (c >> 4) * KSTR + (c & 15) * 16) = rk[i];
      char* vp = base + 64 * KSTR + (c >> 3) * VSTR + (c & 7) * 16;
      u32x2 v0, v1; v0[0] = rv[i][0]; v0[1] = rv[i][1]; v1[0] = rv[i][2]; v1[1] = rv[i][3];
      *(u32x2*)vp = v0; *(u32x2*)(vp + 8) = v1;
    }
  };
  f32x16 oacc[4];
#pragma unroll
  for (int a = 0; a < 4; ++a)
#pragma unroll
    for (int i = 0; i < 16; ++i) oacc[a][i] = 0.f;
  float m_run = NEG, l_run = 0.f;
  gload(n, kt); lstore(0); __syncthreads();
  int st = 0;
  while (n <= qb) {
    int n2 = n, kt2 = kt + 1;
    if (kt2 >= ((n == qb) ? own_tiles : 4)) { kt2 = 0; ++n2; while (n2 < qb && !((blkmask >> n2) & 1u)) ++n2; }
    const bool has_next = (n2 <= qb);
    if (has_next) gload(n2, kt2);
    const char* Kb = lds + st * ASTAGE + lq * KSTR + hl * 16; const char* Vb = lds + st * ASTAGE + 64 * KSTR + lq * VSTR + hl * 8;
    const bool own = (n == qb);
    const bool allowed = own || ((selmask >> n) & 1u);
    const int key0 = n * 256 + kt * 64;
#pragma unroll
    for (int mf = 0; mf < 2; ++mf) {
      f32x16 sacc;
#pragma unroll
      for (int i = 0; i < 16; ++i) sacc[i] = 0.f;
#pragma unroll
      for (int ks = 0; ks < 8; ++ks) {
        const bf16x8 a = *(const bf16x8*)(Kb + mf * 32 * KSTR + ks * 32);
        sacc = MFMA32(a, qf[ks], sacc);
      }
      if (own) {
#pragma unroll
        for (int i = 0; i < 16; ++i) { const int kp = key0 + mf * 32 + (i & 3) + 8 * (i >> 2) + 4 * hl; if (kp > myq) sacc[i] = NEG; }
      } else if (!allowed) {
#pragma unroll
        for (int i = 0; i < 16; ++i) sacc[i] = NEG;
      }
      float mt = NEG;
#pragma unroll
      for (int i = 0; i < 16; ++i) mt = fmaxf(mt, sacc[i]);
      mt = fmaxf(mt, __shfl_xor(mt, 32));
      const float mnew = fmaxf(m_run, mt);
      const float muse = (mnew == NEG) ? 0.f : mnew;
      const float alpha = __builtin_amdgcn_exp2f(m_run - muse);
      m_run = mnew;
      float psum = 0.f;
#pragma unroll
      for (int i = 0; i < 16; ++i) { const float pe = __builtin_amdgcn_exp2f(sacc[i] - muse); sacc[i] = pe; psum += pe; }
      l_run = l_run * alpha + psum;
      if (__any(alpha != 1.f)) {
#pragma unroll
        for (int a = 0; a < 4; ++a)
#pragma unroll
          for (int i = 0; i < 16; ++i) oacc[a][i] *= alpha;
      }
      bf16x8 pf[2];
#pragma unroll
      for (int s2 = 0; s2 < 2; ++s2) {
        u32x4 pk;
#pragma unroll
        for (int e = 0; e < 4; ++e) pk[e] = pack2(sacc[8 * s2 + 2 * e], sacc[8 * s2 + 2 * e + 1]);
        pf[s2] = __builtin_bit_cast(bf16x8, pk);
      }
#pragma unroll
      for (int md = 0; md < 4; ++md) {
#pragma unroll
        for (int s2 = 0; s2 < 2; ++s2) {
          const int chunk = 4 * mf + 2 * s2;
          const bf16x4 lo = *(const bf16x4*)(Vb + md * 32 * VSTR + chunk * 16);
          const bf16x4 hi = *(const bf16x4*)(Vb + md * 32 * VSTR + chunk * 16 + 16);
          const bf16x8 a = __builtin_shufflevector(lo, hi, 0, 1, 2, 3, 4, 5, 6, 7);
          oacc[md] = MFMA32(a, pf[s2], oacc[md]);
        }
      }
    }
    if (has_next) lstore(st ^ 1);
    __syncthreads();
    n = n2; kt = kt2; st ^= 1;
  }
  const float ltot = l_run + __shfl_xor(l_run, 32);
  const float inv = 1.f / ltot;
  bf16_t* op = qkv + (tok0 + wv * 32 + lq) * 3072 + h * 128;
#pragma unroll
  for (int md = 0; md < 4; ++md)
#pragma unroll
    for (int i4 = 0; i4 < 4; ++i4) {
      u32x2 o; o[0] = pack2(oacc[md][4 * i4] * inv, oacc[md][4 * i4 + 1] * inv); o[1] = pack2(oacc[md][4 * i4 + 2] * inv, oacc[md][4 * i4 + 3] * inv);
      *(u32x2*)(op + md * 32 + 8 * i4 + 4 * hl) = o;
    }
  __syncthreads();
}

constexpr int NPHASE = 21;

DI GA ga_zero() { GA g; g.A = nullptr; g.lda = 0; g.ksplit = 1 << 30; g.koff2 = 0; g.Bt = nullptr; g.K = 0; g.N = 0; g.MT = 128; g.m_base = 0; g.rss_in = nullptr; g.nparts = 0; g.rss_out = nullptr;
  g.resid = nullptr; g.xout = nullptr; g.xb = nullptr; g.outb = nullptr; g.c0 = nullptr; g.c1 = nullptr; g.c2 = nullptr; g.pp = nullptr; g.auxb = nullptr; g.aux2 = nullptr; g.auxf = nullptr; return g; }

template <int EPI, bool AF32>
DI void run_gemm(const GA& g, char* lds) {
  const int total = (AF32 ? g.MT : (g.MT >> 1)) * (g.N >> 7);
  for (int t = blockIdx.x; t < total; t += gridDim.x) gemm_tile<EPI, AF32>(g, t, lds);
}

DI void mlp_phase(const Pm& p, int layer, int sub, char* lds) {
  char* ws = p.ws;
  const bf16_t* xin = (const bf16_t*)(ws + (layer == 0 ? XB_A : XB_B));
  bf16_t* xmid = (bf16_t*)(ws + (layer == 0 ? XB_B : XB_A));
  bf16_t* xnext = (bf16_t*)(ws + (layer == 0 ? XB_A : XB_B));
  const float* rss_in = (const float*)(ws + (layer == 0 ? RSS_A : RSS_B));
  float* rss_mid = (float*)(ws + (layer == 0 ? RSS_B : RSS_A));
  float* rss_next = (float*)(ws + (layer == 0 ? RSS_A : RSS_B));
  const bf16_t* wup = (const bf16_t*)(ws + (layer == 0 ? W_UP0 : W_UP1));
  const bf16_t* wdn = (const bf16_t*)(ws + (layer == 0 ? W_DN0 : W_DN1));
  const bf16_t* wpj = (const bf16_t*)(ws + (layer == 0 ? W_PPJ0 : W_PPJ1));
  const bf16_t* wgt = (const bf16_t*)(ws + (layer == 0 ? W_PGT0 : W_PGT1));
  if (sub == 0 || sub == 2) {
    const int mb = (sub == 0) ? 0 : 8192;
    GA g = ga_zero(); g.A = xin; g.lda = 1024; g.Bt = wup; g.K = 1024; g.N = 4096; g.MT = 64; g.m_base = mb;
    g.rss_in = rss_in; g.nparts = 16; g.outb = (bf16_t*)(ws + ACT) - (size_t)mb * 4096;
    const int n_up = 32 * 32;
    if (sub == 0) {
      GA q = ga_zero(); q.A = p.in[1] + (size_t)layer * M * 256; q.lda = 256; q.Bt = wpj; q.K = 256; q.N = 1024; q.MT = 128;
      q.xout = (float*)(ws + PPB); q.rss_out = (float*)(ws + RSS_P);
      const int n_pp = 128 * 8;
      const int n_w1 = (layer == 0) ? W1_UNITS : 0;
      const int total = n_up + n_pp + n_w1;
      for (int t = blockIdx.x; t < total; t += gridDim.x) {
        if (t < n_up) gemm_tile<EPI_UP, false>(g, t, lds);
        else if (t < n_up + n_pp) gemm_tile<EPI_PP, true>(q, t - n_up, lds);
        else phase_w1_unit(p, t - n_up - n_pp, lds);
      }
    } else {
      for (int t = blockIdx.x; t < n_up; t += gridDim.x) gemm_tile<EPI_UP, false>(g, t, lds);
    }
  } else if (sub == 1 || sub == 3) {
    const int mb = (sub == 1) ? 0 : 8192;
    GA g = ga_zero(); g.A = (const bf16_t*)(ws + ACT) - (size_t)mb * 4096; g.lda = 4096; g.Bt = wdn; g.K = 4096; g.N = 1024; g.MT = 64; g.m_base = mb;
    g.resid = p.out; g.xout = p.out; g.xb = xmid; g.rss_out = rss_mid;
    run_gemm<EPI_RES, false>(g, lds);
  } else {
    GA g = ga_zero(); g.A = xmid; g.lda = 1024; g.Bt = wgt; g.K = 1024; g.N = 1024; g.MT = 128;
    g.rss_in = (const float*)(ws + RSS_P); g.nparts = 16; g.pp = (const float*)(ws + PPB); g.c0 = p.in[26] + layer * 1024;
    g.resid = p.out; g.xout = p.out; g.xb = xnext; g.rss_out = rss_next;
    run_gemm<EPI_GATE, false>(g, lds);
  }
}

DI void run_phase(const Pm& pin, int ph, char* lds) {
  const Pm& p = pin;
  char* ws = p.ws;
  switch (ph) {
    case 0: phase0(p, lds); break;
    case 1: {
      GA g = ga_zero(); g.A = ws + XB_A; g.lda = 1024; g.Bt = (const bf16_t*)(ws + W_WIN); g.K = 1024; g.N = 3840; g.MT = 128;
      g.rss_in = (const float*)(ws + RSS_X0); g.nparts = 1; g.outb = (bf16_t*)(ws + U_OFF); g.c0 = (const float*)(ws + LBOFF); g.aux2 = (bf16_t*)(ws + BND);
      run_gemm<EPI_WIN, false>(g, lds);
    } break;
    case 2: {
      const int wv = tidx() >> 6;
      for (int t = blockIdx.x * 4 + wv; t < 1024; t += gridDim.x * 4) tokshift_unit(p, t);
    } break;
    case 3: {
      GA gw = ga_zero(); gw.A = (const bf16_t*)(ws + U_OFF) + 2048 + 1536; gw.lda = 3840; gw.Bt = (const bf16_t*)(ws + W_W2); gw.K = 64; gw.N = 512; gw.MT = 128;
      gw.c0 = p.in[9]; gw.outb = (bf16_t*)(ws + LOGD);
      GA gq = ga_zero(); gq.A = (const bf16_t*)(ws + U_OFF) + 2048 + 1600; gq.lda = 3840; gq.Bt = (const bf16_t*)(ws + W_A2); gq.K = 64; gq.N = 512; gq.MT = 128;
      gq.c0 = p.in[11]; gq.outb = (bf16_t*)(ws + AARR);
      for (int t = blockIdx.x; t < 512; t += gridDim.x) { if (t < 256) gemm_tile<EPI_LW, false>(gw, t, lds); else gemm_tile<EPI_LA, false>(gq, t - 256, lds); }
    } break;
    case 4: {
      for (int u = blockIdx.x; u < 256; u += gridDim.x) { if (u < 128) rwkv_unit(p, u, lds); else hgrn_unit(p, u - 128, lds); }
    } break;
    case 5: {
      GA g = ga_zero(); g.A = (const bf16_t*)(ws + U_OFF) + 2048 + 1664; g.lda = 3840; g.Bt = (const bf16_t*)(ws + W_G2); g.K = 128; g.N = 512; g.MT = 128;
      g.auxb = (const bf16_t*)(ws + Y_OFF); g.auxf = (const float*)(ws + BONUS); g.c0 = p.in[17]; g.c1 = p.in[18]; g.outb = (bf16_t*)(ws + U_OFF);
      for (int t = blockIdx.x; t < 256 + 256; t += gridDim.x) { if (t < 256) gemm_tile<EPI_POSTB, false>(g, t, lds); else oapost_unit(p, t - 256); }
    } break;
    case 6: {
      GA g = ga_zero(); g.A = ws + U_OFF; g.lda = 3840; g.ksplit = 512; g.koff2 = 1536; g.Bt = (const bf16_t*)(ws + W_WOUT); g.K = 1024; g.N = 1024; g.MT = 128;
      g.resid = p.in[0]; g.xout = p.out; g.xb = (bf16_t*)(ws + XB_A); g.rss_out = (float*)(ws + RSS_A);
      run_gemm<EPI_RES, false>(g, lds);
    } break;
    case 7: case 8: case 9: case 10: case 11: mlp_phase(p, 0, ph - 7, lds); break;
    case 12: {
      GA g = ga_zero(); g.A = ws + XB_A; g.lda = 1024; g.Bt = (const bf16_t*)(ws + W_QKV); g.K = 1024; g.N = 3072; g.MT = 128;
      g.rss_in = (const float*)(ws + RSS_A); g.nparts = 16; g.outb = (bf16_t*)(ws + QKV);
      run_gemm<EPI_QKV, false>(g, lds);
    } break;
    case 13: for (int u = blockIdx.x; u < 512; u += gridDim.x) attnprep_unit(p, u, lds); break;
    case 14: for (int u = blockIdx.x; u < 1024; u += gridDim.x) attn_unit(p, u, lds); break;
    case 15: {
      GA g = ga_zero(); g.A = ws + QKV; g.lda = 3072; g.Bt = (const bf16_t*)(ws + W_WO); g.K = 1024; g.N = 1024; g.MT = 128;
      g.resid = p.out; g.xout = p.out; g.xb = (bf16_t*)(ws + XB_B); g.rss_out = (float*)(ws + RSS_B);
      run_gemm<EPI_RES, false>(g, lds);
    } break;
    case 16: case 17: case 18: case 19: case 20: mlp_phase(p, 1, ph - 16, lds); break;
    default: break;
  }
}

__global__ void __launch_bounds__(256, 2) mega(Pm p, int ph_lo, int ph_hi) {
  extern __shared__ __attribute__((aligned(16))) char lds[];
  cg::grid_group grid = cg::this_grid();
#ifdef PROBE_LO
  long long pt0 = 0, pt1 = 0;
#endif
  for (int ph = ph_lo; ph < ph_hi; ++ph) {
#ifdef PROBE_LO
    if (ph == PROBE_LO) pt0 = wall_clock64();
#endif
    run_phase(p, ph, lds);
    if (ph + 1 < ph_hi) grid.sync();
#ifdef PROBE_LO
    if (ph == PROBE_HI - 1) pt1 = wall_clock64();
#endif
  }
#ifdef PROBE_LO
  if (blockIdx.x == 0 && tidx() == 0) { const long long te = wall_clock64(); while (wall_clock64() - te < (pt1 - pt0)) __builtin_amdgcn_s_sleep(8); }
#endif
}

extern "C" void kernel_launch(void* const* d_in, const int* in_sizes, int n_in, void* d_out, int out_size, void* d_ws, size_t ws_size, hipStream_t stream) {
  static int grid_blocks = 0;
  if (grid_blocks == 0) {
    if (n_in != 28 || out_size != M * 1024 || ws_size < WS_NEED) { fprintf(stderr, "kernel_launch: unexpected problem (n_in %d out %d ws %zu)\n", n_in, out_size, ws_size); grid_blocks = -1; return; }
    int dev = 0, cus = 0, per_cu = 0;
    hipGetDevice(&dev);
    hipDeviceGetAttribute(&cus, hipDeviceAttributeMultiprocessorCount, dev);
    if (hipFuncSetAttribute((const void*)mega, hipFuncAttributeMaxDynamicSharedMemorySize, LDS_BYTES) != hipSuccess) { fprintf(stderr, "hipFuncSetAttribute failed\n"); grid_blocks = -1; return; }
    hipOccupancyMaxActiveBlocksPerMultiprocessor(&per_cu, (const void*)mega, 256, LDS_BYTES);
    if (per_cu < 1) { fprintf(stderr, "occupancy query gave %d\n", per_cu); grid_blocks = -1; return; }
    if (per_cu > 2) per_cu = 2;
    grid_blocks = cus * per_cu;
    fprintf(stderr, "kernel_launch: %d CUs x %d blocks\n", cus, per_cu);
  }
  if (grid_blocks < 0) return;
  Pm p{};
  for (int i = 0; i < 28; ++i) p.in[i] = (const float*)d_in[i];
  p.out = (float*)d_out; p.ws = (char*)d_ws;
#if ONE_LAUNCH
  int lo = 0, hi = NPHASE;
  void* args[] = {&p, &lo, &hi};
  hipError_t e = hipLaunchCooperativeKernel((const void*)mega, dim3(grid_blocks), dim3(256), args, LDS_BYTES, stream);
  if (e != hipSuccess) fprintf(stderr, "cooperative launch failed: %s (grid %d)\n", hipGetErrorString(e), grid_blocks);
#else
  for (int ph = 0; ph < NPHASE; ++ph) hipLaunchKernelGGL(mega, dim3(grid_blocks), dim3(256), LDS_BYTES, stream, p, ph, ph + 1);
#endif
}
```
